# Optimizing an MI355X kernel written in HIP

```python
import jax, jax.numpy as jnp
from jax import lax
import numpy as np

D_MODEL = 1024
BATCH = 8
SEQ = 2048
DEPTH = 1
DEC_BATCH = 128
DEC_SEQ = 8
PAST_LEN = 16384
PAGE_SIZE = 128

HEAD_DIM = 128
N_RET_HEADS = 4
N_ML_HEADS = 4
RET_W = N_RET_HEADS * HEAD_DIM
ML_W = N_ML_HEADS * HEAD_DIM
MIX_W = RET_W + ML_W
IN_COLS = 4 * RET_W + 4 * ML_W + 2 * N_ML_HEADS
D_FF = 2816
CONV_W = 3
CHUNK = 128
ROPE_BASE = 10000.0
EPS = 1e-6
M_INIT = -1e30

kernel_name = "retnet_mlstm_parallel_heads_convffn_step"


def rmsnorm(x, g):
    xf = x.astype(jnp.float32)
    y = xf * lax.rsqrt(jnp.mean(xf * xf, axis=-1, keepdims=True) + EPS)
    return (y * g.astype(jnp.float32)).astype(x.dtype)


def head_groupnorm(h, g):
    mu = jnp.mean(h, axis=-1, keepdims=True)
    var = jnp.mean(jnp.square(h - mu), axis=-1, keepdims=True)
    y = (h - mu) * lax.rsqrt(var + EPS)
    B, L, H, D = h.shape
    return y.reshape(B, L, H * D) * g.astype(jnp.float32)


def rotary(x, pos):
    D = x.shape[-1]
    freqs = ROPE_BASE ** (-jnp.arange(0, D, 2, dtype=jnp.float32) / D)
    ang = pos.astype(jnp.float32)[:, None] * freqs[None, :]
    cos = jnp.cos(ang)[None, :, None, :]
    sin = jnp.sin(ang)[None, :, None, :]
    x1, x2 = x[..., : D // 2], x[..., D // 2:]
    return jnp.concatenate([x1 * cos - x2 * sin, x1 * sin + x2 * cos], axis=-1)


def to_chunks(x, c):
    B, L, H = x.shape[:3]
    x = x.reshape((B, L // c, c, H) + x.shape[3:])
    return jnp.swapaxes(jnp.moveaxis(x, 1, 0), 2, 3)


def from_chunks(x):
    nc, B, H, c, D = x.shape
    x = jnp.moveaxis(jnp.swapaxes(x, 2, 3), 0, 1)
    return x.reshape(B, nc * c, H, D)


def retention_chunked(q, k, v, S0):
    L = q.shape[1]
    H = q.shape[2]
    c = min(CHUNK, L)
    lg = jnp.log(1.0 - 2.0 ** (-5.0 - jnp.arange(H, dtype=jnp.float32)))
    idx = jnp.arange(c)
    causal = idx[:, None] >= idx[None, :]
    expo = (idx[:, None] - idx[None, :]).astype(jnp.float32)[None] * lg[:, None, None]
    dmat = jnp.where(causal[None], jnp.exp(jnp.where(causal[None], expo, 0.0)), 0.0)
    xi = jnp.exp((idx + 1).astype(jnp.float32)[None, :] * lg[:, None])
    zeta = jnp.exp((c - 1 - idx).astype(jnp.float32)[None, :] * lg[:, None])
    chunk_decay = jnp.exp(c * lg)

    def step(S, inp):
        qc, kc, vc = inp
        scores = jnp.einsum('bhnd,bhmd->bhnm', qc, kc) * dmat[None]
        out = (jnp.einsum('bhnm,bhmv->bhnv', scores, vc)
               + jnp.einsum('bhnd,bhdv->bhnv', qc, S) * xi[None, :, :, None])
        S_new = (S * chunk_decay[None, :, None, None]
                 + jnp.einsum('bhmd,bhmv->bhdv', kc * zeta[None, :, :, None], vc))
        return S_new, out

    S_fin, outs = lax.scan(step, S0, (to_chunks(q, c), to_chunks(k, c), to_chunks(v, c)))
    return from_chunks(outs), S_fin


def mlstm_chunked(q, k, v, ig, fg, C0, n0, m0):
    L = q.shape[1]
    c = min(CHUNK, L)
    logf = jax.nn.log_sigmoid(fg)
    idx = jnp.arange(c)
    causal = idx[:, None] >= idx[None, :]
    ig_c = jnp.moveaxis(ig.reshape(ig.shape[0], L // c, c, ig.shape[2]), 1, 0).swapaxes(2, 3)
    lf_c = jnp.moveaxis(logf.reshape(logf.shape[0], L // c, c, logf.shape[2]), 1, 0).swapaxes(2, 3)

    def step(carry, inp):
        C, n, m = carry
        qc, kc, vc, ic, lfc = inp
        b = jnp.cumsum(lfc, axis=-1)
        logw = b[..., :, None] - b[..., None, :] + ic[..., None, :]
        logw = jnp.where(causal, logw, -jnp.inf)
        m_t = jnp.maximum(b + m[..., None], jnp.max(logw, axis=-1))
        w = jnp.exp(logw - m_t[..., None])
        inter = jnp.exp(b + m[..., None] - m_t)
        s = jnp.einsum('bhtd,bhsd->bhts', qc, kc) * w
        num = (jnp.einsum('bhts,bhsv->bhtv', s, vc)
               + inter[..., None] * jnp.einsum('bhvd,bhtd->bhtv', C, qc))
        den_dot = jnp.sum(s, axis=-1) + inter * jnp.einsum('bhd,bhtd->bht', n, qc)
        den = jnp.maximum(jnp.abs(den_dot), jnp.exp(-m_t))
        h = num / den[..., None]
        m_new = m_t[..., -1]
        wl = jnp.exp(b[..., -1:] - b + ic - m_new[..., None])
        decay = jnp.exp(b[..., -1] + m - m_new)
        C_new = decay[..., None, None] * C + jnp.einsum('bhsv,bhsd->bhvd', vc * wl[..., None], kc)
        n_new = decay[..., None] * n + jnp.einsum('bhs,bhsd->bhd', wl, kc)
        return (C_new, n_new, m_new), h

    (C_f, n_f, m_f), outs = lax.scan(
        step, (C0, n0, m0),
        (to_chunks(q, c), to_chunks(k, c), to_chunks(v, c), ig_c, lf_c))
    return from_chunks(outs), C_f, n_f, m_f


def decoder_layer(x, pos, S_ret, C, n, m, conv_buf,
                  pre_mix_g, w_in, b_g, ret_g, ml_g, w_out, post_mix_g,
                  pre_ffn_g, w_up, conv_w, conv_b, w_down, post_ffn_g):
    B, L, _ = x.shape
    f32 = jnp.float32
    h = rmsnorm(x, pre_mix_g)
    proj = (h @ w_in).astype(f32)
    o = 0
    def take(width):
        nonlocal o
        seg = proj[..., o:o + width]
        o += width
        return seg
    q_r = take(RET_W).reshape(B, L, N_RET_HEADS, HEAD_DIM)
    k_r = take(RET_W).reshape(B, L, N_RET_HEADS, HEAD_DIM)
    v_r = take(RET_W).reshape(B, L, N_RET_HEADS, HEAD_DIM)
    g_r = take(RET_W)
    q_m = take(ML_W).reshape(B, L, N_ML_HEADS, HEAD_DIM)
    k_m = take(ML_W).reshape(B, L, N_ML_HEADS, HEAD_DIM)
    v_m = take(ML_W).reshape(B, L, N_ML_HEADS, HEAD_DIM)
    o_m = take(ML_W)
    gates = take(2 * N_ML_HEADS) + b_g.astype(f32)
    i_pre, f_pre = gates[..., :N_ML_HEADS], gates[..., N_ML_HEADS:]

    scale = HEAD_DIM ** -0.5
    q_r = rotary(q_r, pos)
    k_r = rotary(k_r, pos) * scale
    ret_out, S_new = retention_chunked(q_r, k_r, v_r, S_ret.astype(f32))
    ret_y = head_groupnorm(ret_out, ret_g) * jax.nn.silu(g_r)
    ml_out, C_new, n_new, m_new = mlstm_chunked(
        q_m, k_m * scale, v_m, i_pre, f_pre,
        C.astype(f32), n.astype(f32), m.astype(f32))
    ml_y = head_groupnorm(ml_out, ml_g) * jax.nn.sigmoid(o_m)

    mix = jnp.concatenate([ret_y, ml_y], axis=-1).astype(x.dtype) @ w_out
    x = x + rmsnorm(mix, post_mix_g)

    h2 = rmsnorm(x, pre_ffn_g)
    up = h2 @ w_up
    padded = jnp.concatenate([conv_buf.astype(up.dtype), up], axis=1)
    conv = sum(padded[:, j:j + L] * conv_w[j] for j in range(CONV_W)) + conv_b
    new_buf = padded[:, L:]
    gate, val = conv[..., :D_FF], conv[..., D_FF:]
    ffn = (jax.nn.gelu(gate.astype(f32), approximate=True) * val.astype(f32)).astype(x.dtype) @ w_down
    x = x + rmsnorm(ffn, post_ffn_g)
    return x, S_new, C_new, n_new, m_new, new_buf


def setup_inputs(seed: int = 0) -> dict:
    key = jax.random.key(seed)
    ks = jax.random.split(key, 24)
    f32 = jnp.float32
    nrm = lambda k, shape, s: jax.random.normal(k, shape, f32) * s
    gain = lambda k, shape: 1.0 + 0.05 * jax.random.normal(k, shape, f32)
    f_bias = jnp.linspace(3.0, 6.0, N_ML_HEADS, dtype=f32)
    b_gates = jnp.concatenate([
        nrm(ks[0], (DEPTH, N_ML_HEADS), 0.01),
        f_bias[None] + nrm(ks[1], (DEPTH, N_ML_HEADS), 0.01)], axis=-1)
    return {
        "x_prompt": nrm(ks[2], (BATCH, SEQ, D_MODEL), 1.0),
        "x_sample": nrm(ks[3], (DEC_BATCH, DEC_SEQ, D_MODEL), 1.0),
        "state_ret": nrm(ks[4], (DEPTH, DEC_BATCH, N_RET_HEADS, HEAD_DIM, HEAD_DIM), 0.1),
        "state_mlstm_C": nrm(ks[5], (DEPTH, DEC_BATCH, N_ML_HEADS, HEAD_DIM, HEAD_DIM), 0.1),
        "state_mlstm_n": nrm(ks[6], (DEPTH, DEC_BATCH, N_ML_HEADS, HEAD_DIM), 0.1),
        "state_mlstm_m": nrm(ks[7], (DEPTH, DEC_BATCH, N_ML_HEADS), 1.0),
        "cache_ffn_conv": nrm(ks[8], (DEPTH, DEC_BATCH, CONV_W - 1, 2 * D_FF), 1.0),
        "pre_mix_gain": gain(ks[9], (DEPTH, D_MODEL)),
        "w_in": nrm(ks[10], (DEPTH, D_MODEL, IN_COLS), D_MODEL ** -0.5),
        "b_gates": b_gates,
        "ret_head_gain": gain(ks[11], (DEPTH, RET_W)),
        "mlstm_head_gain": gain(ks[12], (DEPTH, ML_W)),
        "w_out": nrm(ks[13], (DEPTH, MIX_W, D_MODEL), MIX_W ** -0.5),
        "post_mix_gain": gain(ks[14], (DEPTH, D_MODEL)),
        "pre_ffn_gain": gain(ks[15], (DEPTH, D_MODEL)),
        "w_up": nrm(ks[16], (DEPTH, D_MODEL, 2 * D_FF), D_MODEL ** -0.5),
        "conv_w": nrm(ks[17], (DEPTH, CONV_W, 2 * D_FF), CONV_W ** -0.5),
        "conv_b": nrm(ks[18], (DEPTH, 2 * D_FF), 0.02),
        "w_down": nrm(ks[19], (DEPTH, D_FF, D_MODEL), D_FF ** -0.5),
        "post_ffn_gain": gain(ks[20], (DEPTH, D_MODEL)),
    }


def reference(x_prompt, x_sample, state_ret, state_mlstm_C, state_mlstm_n, state_mlstm_m,
              cache_ffn_conv, pre_mix_gain, w_in, b_gates, ret_head_gain, mlstm_head_gain,
              w_out, post_mix_gain, pre_ffn_gain, w_up, conv_w, conv_b, w_down, post_ffn_gain):
    f32 = jnp.float32
    Bp, Lp, _ = x_prompt.shape
    Ls = x_sample.shape[1]
    pos_p = jnp.arange(Lp, dtype=jnp.int32)
    pos_s = PAST_LEN + jnp.arange(Ls, dtype=jnp.int32)
    yp, ys = x_prompt, x_sample
    out_Sp, out_Ss, out_Cp, out_Cs = [], [], [], []
    out_np, out_ns, out_mp, out_ms, out_bp, out_bs = [], [], [], [], [], []
    for l in range(DEPTH):
        params = (pre_mix_gain[l], w_in[l], b_gates[l], ret_head_gain[l], mlstm_head_gain[l],
                  w_out[l], post_mix_gain[l], pre_ffn_gain[l], w_up[l], conv_w[l], conv_b[l],
                  w_down[l], post_ffn_gain[l])
        S0 = jnp.zeros((Bp, N_RET_HEADS, HEAD_DIM, HEAD_DIM), f32)
        C0 = jnp.zeros((Bp, N_ML_HEADS, HEAD_DIM, HEAD_DIM), f32)
        n0 = jnp.zeros((Bp, N_ML_HEADS, HEAD_DIM), f32)
        m0 = jnp.full((Bp, N_ML_HEADS), M_INIT, f32)
        buf0 = jnp.zeros((Bp, CONV_W - 1, 2 * D_FF), x_prompt.dtype)
        yp, Sp, Cp, np_, mp, bp = decoder_layer(yp, pos_p, S0, C0, n0, m0, buf0, *params)
        ys, Ss, Cs, ns, ms, bs = decoder_layer(ys, pos_s, state_ret[l], state_mlstm_C[l],
                                               state_mlstm_n[l], state_mlstm_m[l],
                                               cache_ffn_conv[l], *params)
        out_Sp.append(Sp); out_Ss.append(Ss)
        out_Cp.append(Cp); out_Cs.append(Cs)
        out_np.append(np_); out_ns.append(ns)
        out_mp.append(mp); out_ms.append(ms)
        out_bp.append(bp); out_bs.append(bs)
    return (yp, ys,
            jnp.stack(out_Sp), jnp.stack(out_Ss),
            jnp.stack(out_Cp), jnp.stack(out_Cs),
            jnp.stack(out_np), jnp.stack(out_ns),
            jnp.stack(out_mp), jnp.stack(out_ms),
            jnp.stack(out_bp), jnp.stack(out_bs))
```

```cpp
#include <hip/hip_runtime.h>
#include <hip/hip_cooperative_groups.h>
#include <cstdio>
namespace cg = cooperative_groups;
namespace pg8 {
#define PG8_LAS __attribute__((address_space(3)))
typedef unsigned short bf16_t;
typedef short bf16x8 __attribute__((ext_vector_type(8)));
typedef float f32x4 __attribute__((ext_vector_type(4)));
typedef unsigned u32x4 __attribute__((ext_vector_type(4)));
constexpr int BM = 256, BK = 64, HALF = 128, HTB = HALF * BK * 2  , STAGE_BYTES = 8 * HTB, NXCD = 8, WGM = 8;

__host__ __device__ __forceinline__ int lds_byte(int r, int c) { const int st = (r >> 4) * 2 + (c >> 5), rr = r & 15, cc = c & 31, ob = rr * 64 + cc * 2; return st * 1024 + (ob ^ (((ob >> 9) & 1) << 5)); }
__host__ __device__ __forceinline__ void stage_rc(int b, int& R, int& C) { const int st = b / 1024, sb = b % 1024, swz = sb ^ (((sb >> 9) & 1) << 5); R = (st >> 1) * 16 + swz / 64; C = (st & 1) * 32 + (swz % 64) / 2; }
__host__ __device__ __forceinline__ int perm32(int rho) { const int n = rho >> 4, i = rho & 15; return 8 * (i >> 2) + 4 * n + (i & 3); }

struct Unit { int pm, pn; };
struct Gemm { const bf16_t* A; const bf16_t* Bt; int M, N, K; };

struct StaticOrder {
    int nM, nN, nwg, G, c;
    __host__ __device__ void init(int M, int N, int G_, int c_) { nM = M / BM; nN = N / BM; nwg = nM * nN; G = G_; c = c_; }
    __host__ __device__ bool next(int i, Unit& u) const {
        const long L = (long)i * G + c; if (L >= nwg) return false;
        int wgid = (int)L; { const int q = nwg / NXCD, r = nwg % NXCD, xcd = wgid % NXCD, off = wgid / NXCD; wgid = (xcd < r ? xcd * (q + 1) : r * (q + 1) + (xcd - r) * q) + off; }
        const int nig = WGM * nN, gid = wgid / nig, fm = gid * WGM, gsz = (nM - fm) < WGM ? (nM - fm) : WGM;
        u.pm = fm + ((wgid % nig) % gsz); u.pn = (wgid % nig) / gsz; return true;
    }
    __device__ __forceinline__ void a_ready(const Unit&) const {}
    __device__ __forceinline__ void done(const Unit&) const {}
};
struct CountedOrder : StaticOrder {
    const unsigned* ready; unsigned need; unsigned* tmo;
    __device__ __forceinline__ void a_ready(const Unit& u) const {
        if (threadIdx.x < 64) {
            const unsigned long long t0 = __builtin_amdgcn_s_memrealtime(); unsigned polls = 0;
            while ((unsigned)__builtin_amdgcn_readfirstlane(__hip_atomic_load(ready + 64 * u.pm, __ATOMIC_RELAXED, __HIP_MEMORY_SCOPE_AGENT)) < need) {
                if ((++polls & 255u) == 0u && __builtin_amdgcn_readfirstlane(__hip_atomic_load(tmo, __ATOMIC_RELAXED, __HIP_MEMORY_SCOPE_AGENT)) != 0u) break;
                if (__builtin_amdgcn_s_memrealtime() - t0 > 2000000ull) {
                    if (threadIdx.x == 0) { unsigned expect = 0u; __hip_atomic_compare_exchange_strong(tmo + 1, &expect, 0x600u | (unsigned)(u.pm & 0xff), __ATOMIC_RELAXED, __ATOMIC_RELAXED, __HIP_MEMORY_SCOPE_AGENT); __hip_atomic_store(tmo, 1u, __ATOMIC_RELAXED, __HIP_MEMORY_SCOPE_AGENT); }
                    break; }
                __builtin_amdgcn_s_sleep(2); }
            __builtin_amdgcn_fence(__ATOMIC_ACQUIRE, "agent");
            asm volatile("s_waitcnt vmcnt(0)" ::: "memory");
        }
#if !defined(BROKEN_HOOK_NO_BARRIER)
        asm volatile("" ::: "memory"); __builtin_amdgcn_s_barrier(); asm volatile("" ::: "memory");
#endif
    }
};

__device__ __forceinline__ unsigned cvt_pk_bf16(float lo, float hi) { unsigned r; asm volatile("v_cvt_pk_bf16_f32 %0, %1, %2" : "=v"(r) : "v"(lo), "v"(hi)); return r; }
typedef float f32x2 __attribute__((ext_vector_type(2)));
__device__ __forceinline__ f32x2 gelu_pk(f32x2 v) {
    const f32x2 av = __builtin_elementwise_abs(v), d = av * 0.2316418882f + 1.0f;
    f32x2 t; t.x = __builtin_amdgcn_rcpf(d.x); t.y = __builtin_amdgcn_rcpf(d.y);
    f32x2 q = t * 0.5307027145f + (-0.7265760135f); q = q * t + 0.7107068705f; q = q * t + (-0.142248368f); q = q * t + 0.127414796f; q = q * t;
    const f32x2 s = (v * v) * (-0.72134752044f);
    f32x2 e; e.x = __builtin_amdgcn_exp2f(s.x); e.y = __builtin_amdgcn_exp2f(s.y);
    const f32x2 m = v * (q * e), r = v - m;
    f32x2 o; o.x = v.x < 0.f ? m.x : r.x; o.y = v.y < 0.f ? m.y : r.y; return o;
}

struct EpiF32 {
    static constexpr bool PERM = false, AFTER_DRAIN = false;
    float* C; int ldc; const float* bias;
    __device__ __forceinline__ void operator()(const f32x4 (&acc)[2][2][4][2], const Unit& u, int wr, int wc, int fr, int fq) const {
        const int row0 = u.pm * BM + wr * 64 + fr, col0 = u.pn * BM + wc * 32 + 4 * fq;
        f32x4 bv[2][2];
#pragma unroll
        for (int bj = 0; bj < 2; ++bj)
#pragma unroll
            for (int n = 0; n < 2; ++n) bv[bj][n] = bias ? *(const f32x4*)(bias + col0 + bj * HALF + n * 16) : (f32x4){0.f, 0.f, 0.f, 0.f};
#pragma unroll
        for (int ai = 0; ai < 2; ++ai)
#pragma unroll
            for (int m = 0; m < 4; ++m) { float* rowp = C + (size_t)(row0 + ai * HALF + m * 16) * ldc + col0;
#pragma unroll
                for (int bj = 0; bj < 2; ++bj)
#pragma unroll
                    for (int n = 0; n < 2; ++n) *(f32x4*)(rowp + bj * HALF + n * 16) = acc[ai][bj][m][n] + bv[bj][n]; }
    }
};
template <int ACT  > struct EpiBf16 {
    static constexpr bool PERM = true, AFTER_DRAIN = false;
    bf16_t* O; int ldc; const float* bias; int split_cols; size_t split_stride;
    __device__ __forceinline__ void operator()(const f32x4 (&acc)[2][2][4][2], const Unit& u, int wr, int wc, int fr, int fq) const {
        const int row0 = u.pm * BM + wr * 64 + fr; int colt = u.pn * BM; bf16_t* base = O;
        if (split_cols) { const int t = colt / split_cols; base += (size_t)t * split_stride; colt -= t * split_cols; }
        const int col0 = colt + wc * 32 + 8 * fq, bcol0 = u.pn * BM + wc * 32 + 8 * fq;
        f32x4 bv[2][2];
#pragma unroll
        for (int bj = 0; bj < 2; ++bj)
#pragma unroll
            for (int n = 0; n < 2; ++n) bv[bj][n] = bias ? *(const f32x4*)(bias + bcol0 + bj * HALF + 4 * n) : (f32x4){0.f, 0.f, 0.f, 0.f};
#pragma unroll
        for (int ai = 0; ai < 2; ++ai)
#pragma unroll
            for (int m = 0; m < 4; ++m) { bf16_t* rowp = base + (size_t)(row0 + ai * HALF + m * 16) * ldc + col0;
#pragma unroll
                for (int bj = 0; bj < 2; ++bj) { f32x4 v0 = acc[ai][bj][m][0] + bv[bj][0], v1 = acc[ai][bj][m][1] + bv[bj][1];
                    if (ACT == 1) { f32x2 a = gelu_pk((f32x2){v0[0], v0[1]}), b = gelu_pk((f32x2){v0[2], v0[3]}), c = gelu_pk((f32x2){v1[0], v1[1]}), d = gelu_pk((f32x2){v1[2], v1[3]});
                        v0 = (f32x4){a.x, a.y, b.x, b.y}; v1 = (f32x4){c.x, c.y, d.x, d.y}; }
                    if (ACT == 2) {
#pragma unroll
                        for (int j = 0; j < 4; ++j) { v0[j] = 0.5f * v0[j] * (1.0f + erff(v0[j] * 0.70710678f)); v1[j] = 0.5f * v1[j] * (1.0f + erff(v1[j] * 0.70710678f)); } }
                    u32x4 w; w.x = cvt_pk_bf16(v0[0], v0[1]); w.y = cvt_pk_bf16(v0[2], v0[3]); w.z = cvt_pk_bf16(v1[0], v1[1]); w.w = cvt_pk_bf16(v1[2], v1[3]);
                    *(u32x4*)(rowp + bj * HALF) = w; } }
    }
};

struct PanelStats {
    unsigned* xbuf;
    unsigned* cnt;
    unsigned* tmo;
    int ntn; float eps;
    unsigned code;
    __device__ __forceinline__ bool run(const f32x4 (&v)[2][2][4][2], const Unit& u, int wr, int wc, int fr, int fq, PG8_LAS unsigned char* lds, int wid, int lane) const {
        typedef float f32x2v __attribute__((ext_vector_type(2)));
        PG8_LAS f32x2v* P = (PG8_LAS f32x2v*)lds;
        PG8_LAS f32x2v* S = (PG8_LAS f32x2v*)(lds + 8192);
        PG8_LAS unsigned* flag = (PG8_LAS unsigned*)(lds + 8192 + 2048);
#pragma unroll
        for (int ai = 0; ai < 2; ++ai)
#pragma unroll
            for (int m = 0; m < 4; ++m) {
                float s = 0.f;
#pragma unroll
                for (int bj = 0; bj < 2; ++bj)
#pragma unroll
                    for (int n = 0; n < 2; ++n) { const f32x4 x = v[ai][bj][m][n]; s += (x[0] + x[1]) + (x[2] + x[3]); }
                s += __shfl_xor(s, 16); s += __shfl_xor(s, 32);
                const float mw = s * (1.0f / 64.0f); float q = 0.f;
#pragma unroll
                for (int bj = 0; bj < 2; ++bj)
#pragma unroll
                    for (int n = 0; n < 2; ++n) { const f32x4 d = v[ai][bj][m][n] - mw; q += (d[0] * d[0] + d[1] * d[1]) + (d[2] * d[2] + d[3] * d[3]); }
                q += __shfl_xor(q, 16); q += __shfl_xor(q, 32);
                if (fq == 0) P[(ai * HALF + wr * 64 + m * 16 + fr) * 4 + wc] = (f32x2v){mw, q};
            }
        asm volatile("s_waitcnt lgkmcnt(0)" ::: "memory"); __builtin_amdgcn_s_barrier(); asm volatile("" ::: "memory");
#if defined(BROKEN_NO_WAIT)
        if (blockIdx.x >= 64) { const long long t0 = clock64(); while (clock64() - t0 < 60000) __builtin_amdgcn_s_sleep(8); }
#endif
        const int row = wid * 32 + (lane & 31);
        if (lane < 32) {
            const f32x2v a = P[row * 4 + 0], b = P[row * 4 + 1], c = P[row * 4 + 2], d = P[row * 4 + 3];
            const float mt = (a.x + b.x + c.x + d.x) * 0.25f;
            const float da = a.x - mt, db = b.x - mt, dc = c.x - mt, dd = d.x - mt;
            const float m2 = (a.y + b.y) + (c.y + d.y) + 64.0f * ((da * da + db * db) + (dc * dc + dd * dd));
            unsigned long long* slot = (unsigned long long*)xbuf + ((size_t)(u.pm * BM + row) * 4 + u.pn);
            __hip_atomic_store(slot, ((unsigned long long)__float_as_uint(m2) << 32) | __float_as_uint(mt), __ATOMIC_RELAXED, __HIP_MEMORY_SCOPE_AGENT);
        }
        asm volatile("s_waitcnt vmcnt(0)" ::: "memory");
        if (lane == 0) __hip_atomic_fetch_add(cnt + 64 * u.pm, 1u, __ATOMIC_RELAXED, __HIP_MEMORY_SCOPE_AGENT);
        if (wid == 0) {
            bool dead = false; const unsigned long long t0 = __builtin_amdgcn_s_memrealtime(); const unsigned want = 8u * (unsigned)ntn;
            for (;;) {
#if defined(BROKEN_NO_WAIT)
                break;
#endif
                if ((unsigned)__builtin_amdgcn_readfirstlane(__hip_atomic_load(cnt + 64 * u.pm, __ATOMIC_RELAXED, __HIP_MEMORY_SCOPE_AGENT)) >= want) break;
                if (__builtin_amdgcn_s_memrealtime() - t0 > 2000000ull) {
                    if (lane == 0) { unsigned expect = 0u; __hip_atomic_compare_exchange_strong(tmo + 1, &expect, code | (unsigned)(u.pm & 0xff), __ATOMIC_RELAXED, __ATOMIC_RELAXED, __HIP_MEMORY_SCOPE_AGENT);
                                     __hip_atomic_store(tmo, 1u, __ATOMIC_RELAXED, __HIP_MEMORY_SCOPE_AGENT); }
                    dead = true; break; }
                __builtin_amdgcn_s_sleep(2);
            }
            __builtin_amdgcn_fence(__ATOMIC_ACQUIRE, "agent");
            if (lane == 0) flag[0] = dead ? 1u : 0u;
        }
        asm volatile("s_waitcnt vmcnt(0) lgkmcnt(0)" ::: "memory"); __builtin_amdgcn_s_barrier(); asm volatile("" ::: "memory");
        const bool bad = flag[0] != 0u;
        if (lane < 32) {
            const unsigned long long* slot = (const unsigned long long*)xbuf + (size_t)(u.pm * BM + row) * 4; float mt[4], m2[4]; float ms = 0.f;
#pragma unroll
            for (int t = 0; t < 4; ++t) { if (t < ntn) { const unsigned long long w = __hip_atomic_load(slot + t, __ATOMIC_RELAXED, __HIP_MEMORY_SCOPE_AGENT); mt[t] = __uint_as_float((unsigned)w); m2[t] = __uint_as_float((unsigned)(w >> 32)); } else { mt[t] = 0.f; m2[t] = 0.f; } ms += mt[t]; }
            const float mean = ms / (float)ntn; float q = 0.f;
#pragma unroll
            for (int t = 0; t < 4; ++t) if (t < ntn) { const float dm = mt[t] - mean; q += m2[t] + 256.0f * dm * dm; }
            S[row] = (f32x2v){mean, 1.0f / sqrtf(q / (256.0f * (float)ntn) + eps)};
        }
        asm volatile("s_waitcnt lgkmcnt(0)" ::: "memory"); __builtin_amdgcn_s_barrier(); asm volatile("" ::: "memory");
        return bad;
    }
};
struct EpiLnRes {
    static constexpr bool PERM = false, AFTER_DRAIN = true;
    const float* base; float* out; int ldc; const float* bias; PanelStats st; unsigned poison;
    __device__ __forceinline__ void refuse(size_t i0, size_t stride, int M, int N) const { const float q = __builtin_nanf(""); for (size_t i = i0; i < (size_t)M * N; i += stride) out[(i / N) * ldc + i % N] = q;
        if (i0 == 0) { unsigned expect = 0u; __hip_atomic_compare_exchange_strong(st.tmo + 1, &expect, 0x7f0u, __ATOMIC_RELAXED, __ATOMIC_RELAXED, __HIP_MEMORY_SCOPE_AGENT); __hip_atomic_store(st.tmo, 1u, __ATOMIC_RELAXED, __HIP_MEMORY_SCOPE_AGENT); } }
    __device__ __forceinline__ void fused(f32x4 (&acc)[2][2][4][2], const Unit& u, int wr, int wc, int fr, int fq, PG8_LAS unsigned char* lds, int wid, int lane) const {
        typedef float f32x2v __attribute__((ext_vector_type(2)));
        const PG8_LAS f32x2v* S = (const PG8_LAS f32x2v*)(lds + 8192);
        const int col0 = u.pn * BM + wc * 32 + 4 * fq;
#pragma unroll
        for (int bj = 0; bj < 2; ++bj)
#pragma unroll
            for (int n = 0; n < 2; ++n) { const f32x4 bv = bias ? *(const f32x4*)(bias + col0 + bj * HALF + n * 16) : (f32x4){0.f, 0.f, 0.f, 0.f};
#pragma unroll
                for (int ai = 0; ai < 2; ++ai)
#pragma unroll
                    for (int m = 0; m < 4; ++m) acc[ai][bj][m][n] += bv; }
        const bool bad = st.run(acc, u, wr, wc, fr, fq, lds, wid, lane) || poison != 0u;
        const float qnan = __builtin_nanf("");
#pragma unroll
        for (int ai = 0; ai < 2; ++ai)
#pragma unroll
            for (int m = 0; m < 4; ++m) { const int r = ai * HALF + wr * 64 + m * 16 + fr; const f32x2v sr = S[r]; const size_t off = (size_t)(u.pm * BM + r) * ldc + col0;
#pragma unroll
                for (int bj = 0; bj < 2; ++bj)
#pragma unroll
                    for (int n = 0; n < 2; ++n) { const f32x4 bs = *(const f32x4*)(base + off + bj * HALF + n * 16); f32x4 o = bs + (acc[ai][bj][m][n] - sr.x) * sr.y;
                        if (bad) o = (f32x4){qnan, qnan, qnan, qnan}; *(f32x4*)(out + off + bj * HALF + n * 16) = o; }
                asm volatile("" ::: "memory"); }
    }
};
struct EpiLnResLn {
    static constexpr bool PERM = false, AFTER_DRAIN = true;
    const float* base; float* out; bf16_t* xn; int ldc; const float* bias; PanelStats st1, st2; unsigned poison;
    __device__ __forceinline__ void refuse(size_t i0, size_t stride, int M, int N) const { const float q = __builtin_nanf(""); for (size_t i = i0; i < (size_t)M * N; i += stride) { const size_t o = (i / N) * ldc + i % N; out[o] = q; xn[o] = (bf16_t)0x7fc0u; }
        if (i0 == 0) { unsigned expect = 0u; __hip_atomic_compare_exchange_strong(st1.tmo + 1, &expect, 0x7f0u, __ATOMIC_RELAXED, __ATOMIC_RELAXED, __HIP_MEMORY_SCOPE_AGENT); __hip_atomic_store(st1.tmo, 1u, __ATOMIC_RELAXED, __HIP_MEMORY_SCOPE_AGENT); } }
    __device__ __forceinline__ void fused(f32x4 (&acc)[2][2][4][2], const Unit& u, int wr, int wc, int fr, int fq, PG8_LAS unsigned char* lds, int wid, int lane) const {
        typedef float f32x2v __attribute__((ext_vector_type(2))); typedef unsigned u32x2v __attribute__((ext_vector_type(2)));
        const PG8_LAS f32x2v* S = (const PG8_LAS f32x2v*)(lds + 8192);
        const int col0 = u.pn * BM + wc * 32 + 4 * fq;
#pragma unroll
        for (int bj = 0; bj < 2; ++bj)
#pragma unroll
            for (int n = 0; n < 2; ++n) { const f32x4 bv = bias ? *(const f32x4*)(bias + col0 + bj * HALF + n * 16) : (f32x4){0.f, 0.f, 0.f, 0.f};
#pragma unroll
                for (int ai = 0; ai < 2; ++ai)
#pragma unroll
                    for (int m = 0; m < 4; ++m) acc[ai][bj][m][n] += bv; }
        bool bad = st1.run(acc, u, wr, wc, fr, fq, lds, wid, lane) || poison != 0u;
        const float qnan = __builtin_nanf("");
#pragma unroll
        for (int ai = 0; ai < 2; ++ai)
#pragma unroll
            for (int m = 0; m < 4; ++m) { const int r = ai * HALF + wr * 64 + m * 16 + fr; const f32x2v sr = S[r]; const size_t off = (size_t)(u.pm * BM + r) * ldc + col0;
#pragma unroll
                for (int bj = 0; bj < 2; ++bj)
#pragma unroll
                    for (int n = 0; n < 2; ++n) { const f32x4 bs = *(const f32x4*)(base + off + bj * HALF + n * 16); acc[ai][bj][m][n] = bs + (acc[ai][bj][m][n] - sr.x) * sr.y; }
                asm volatile("" : "+v"(acc[ai][0][m][0]), "+v"(acc[ai][0][m][1]), "+v"(acc[ai][1][m][0]), "+v"(acc[ai][1][m][1]));
                if (m & 1) asm volatile("" ::: "memory"); }
        const bool bad1 = bad;
        bad = st2.run(acc, u, wr, wc, fr, fq, lds, wid, lane) || bad;
#pragma unroll
        for (int ai = 0; ai < 2; ++ai)
#pragma unroll
            for (int m = 0; m < 4; ++m) { const int r = ai * HALF + wr * 64 + m * 16 + fr; const f32x2v sr = S[r]; const size_t off = (size_t)(u.pm * BM + r) * ldc + col0;
#pragma unroll
                for (int bj = 0; bj < 2; ++bj)
#pragma unroll
                    for (int n = 0; n < 2; ++n) { const f32x4 x1 = acc[ai][bj][m][n]; *(f32x4*)(out + off + bj * HALF + n * 16) = bad1 ? (f32x4){qnan, qnan, qnan, qnan} : x1;
                        const f32x4 o = (x1 - sr.x) * sr.y; u32x2v w; w.x = cvt_pk_bf16(o[0], o[1]); w.y = cvt_pk_bf16(o[2], o[3]);
                        if (bad) { w.x = 0x7fc07fc0u; w.y = 0x7fc07fc0u; } *(u32x2v*)(xn + off + bj * HALF + n * 16) = w; }
                asm volatile("" ::: "memory"); }
    }
};

template <class Epi, class Sched, bool STAMP = false>
__device__ __forceinline__ void gemm_phase(PG8_LAS unsigned char* lds, const Gemm g, const Sched& S, const Epi& E, unsigned long long* stamps) {
    const int tid = threadIdx.x, wid = __builtin_amdgcn_readfirstlane(tid >> 6), lane = tid & 63, wr = wid >> 2, wc = wid & 3, fr = lane & 15, fq = lane >> 4;
    const int K = g.K, nt = K / BK;
    int ts_lo = 0, ts_hi = 0, nts = 0; const unsigned long long rt_entry = STAMP ? (unsigned long long)wall_clock64() : 0ull;
#define PG8_STAMP() do { if (STAMP && wid == 0 && nts < 64) { const unsigned long long _c = (unsigned long long)clock64(); \
        ts_lo = (lane == nts) ? (int)(unsigned)_c : ts_lo; ts_hi = (lane == nts) ? (int)(unsigned)(_c >> 32) : ts_hi; ++nts; } } while (0)
    PG8_STAMP();
    unsigned voffA[2], voffB[2];
#pragma unroll
    for (int i = 0; i < 2; ++i) { int R, C; stage_rc(tid * 16 + i * 8192, R, C); const int Rb = Epi::PERM ? ((R & ~31) + perm32(R & 31)) : R;
        voffA[i] = (unsigned)(R * K + C) * 2u; voffB[i] = (unsigned)(Rb * K + C) * 2u; }
    const size_t kstep = (size_t)(BK * 2);
    const size_t hstep = (size_t)HALF * K * 2;
    const size_t tstep = 2 * hstep;
    const unsigned ldsw = (unsigned)wid * 1024u;
    const int aoff = lds_byte(wr * 64 + fr, fq * 8), boff = lds_byte(wc * 32 + fr, fq * 8);
#define PG8_SA(b, h) (((b) * 2 + (h)) * HTB)
#define PG8_SB(b, h) ((4 + (b) * 2 + (h)) * HTB)
#define PG8_STAGE(bufoff, gbase, voff) do { _Pragma("unroll") for (int _i = 0; _i < 2; ++_i) \
        __builtin_amdgcn_global_load_lds((const unsigned*)((const char*)(gbase) + (voff)[_i]), (PG8_LAS unsigned*)(lds + (bufoff) + ldsw + _i * 8192), 16, 0, 0); } while (0)
#define PG8_LDA(dst, b, h) do { _Pragma("unroll") for (int m = 0; m < 4; ++m) _Pragma("unroll") for (int k = 0; k < 2; ++k) dst[m][k] = *(const PG8_LAS bf16x8*)(lds + PG8_SA(b, h) + aoff + m * 2048 + k * 1024); } while (0)
#define PG8_LDB(dst, b, h) do { _Pragma("unroll") for (int n = 0; n < 2; ++n) _Pragma("unroll") for (int k = 0; k < 2; ++k) dst[n][k] = *(const PG8_LAS bf16x8*)(lds + PG8_SB(b, h) + boff + n * 2048 + k * 1024); } while (0)
#define PG8_MMA(ai, bj, At, Bt) do { __builtin_amdgcn_s_setprio(1); _Pragma("unroll") for (int m = 0; m < 4; ++m) _Pragma("unroll") for (int n = 0; n < 2; ++n) _Pragma("unroll") for (int k = 0; k < 2; ++k) \
        acc[ai][bj][m][n] = __builtin_amdgcn_mfma_f32_16x16x32_bf16(Bt[n][k], At[m][k], acc[ai][bj][m][n], 0, 0, 0); __builtin_amdgcn_s_setprio(0); } while (0)
#define PG8_WAIT_V(n) asm volatile("s_waitcnt vmcnt(" #n ")" ::: "memory")
#define PG8_WAIT_L(n) asm volatile("s_waitcnt lgkmcnt(" #n ")" ::: "memory")
#define PG8_BAR __builtin_amdgcn_s_barrier()
#define PG8_SCHED __builtin_amdgcn_sched_barrier(0)
    Unit cur, nxt; int ui = 0;
    if (!S.next(0, cur)) return;
    f32x4 acc[2][2][4][2];
#pragma unroll
    for (int a = 0; a < 2; ++a)
#pragma unroll
        for (int b = 0; b < 2; ++b)
#pragma unroll
            for (int m = 0; m < 4; ++m)
#pragma unroll
                for (int n = 0; n < 2; ++n) acc[a][b][m][n] = (f32x4){0.f, 0.f, 0.f, 0.f};
    bf16x8 At[4][2], B0[2][2], B1[2][2];
    const char* cA = (const char*)g.A + (size_t)cur.pm * tstep; const char* cB = (const char*)g.Bt + (size_t)cur.pn * tstep;
    S.a_ready(cur);
    PG8_STAGE(PG8_SB(0, 0), cB, voffB); PG8_STAGE(PG8_SA(0, 0), cA, voffA); PG8_STAGE(PG8_SB(0, 1), cB + hstep, voffB); PG8_STAGE(PG8_SA(0, 1), cA + hstep, voffA);
    if (wr == 1) PG8_BAR;
    PG8_WAIT_V(4); PG8_BAR;
    PG8_STAGE(PG8_SB(1, 0), cB + kstep, voffB); PG8_STAGE(PG8_SA(1, 0), cA + kstep, voffA); PG8_STAGE(PG8_SB(1, 1), cB + hstep + kstep, voffB);
    PG8_WAIT_V(6); PG8_BAR;
    PG8_STAMP();
    for (;;) {
        const bool has_next = S.next(ui + 1, nxt);
        const char* nA = has_next ? (const char*)g.A + (size_t)nxt.pm * tstep : cA; const char* nB = has_next ? (const char*)g.Bt + (size_t)nxt.pn * tstep : cB;
        for (int t = 0; t < nt; t += 2) {
            const bool last = (t == nt - 2);
            const char* a1 = cA + (size_t)(t + 1) * kstep;
            const char* a2 = last ? nA : cA + (size_t)(t + 2) * kstep; const char* b2 = last ? nB : cB + (size_t)(t + 2) * kstep;
            const char* a3 = a2 + kstep; const char* b3 = b2 + kstep;
            if (last && has_next) S.a_ready(nxt);
            PG8_LDB(B0, 0, 0); PG8_SCHED; PG8_LDA(At, 0, 0); PG8_STAGE(PG8_SA(1, 1), a1 + hstep, voffA);
            PG8_WAIT_L(8); PG8_BAR; PG8_WAIT_L(0); PG8_MMA(0, 0, At, B0); PG8_BAR; PG8_SCHED;
            PG8_LDB(B1, 0, 1); PG8_STAGE(PG8_SB(0, 0), b2, voffB);
            PG8_BAR; PG8_WAIT_L(0); PG8_MMA(0, 1, At, B1); PG8_BAR;
            PG8_LDA(At, 0, 1); PG8_STAGE(PG8_SA(0, 0), a2, voffA);
            PG8_BAR; PG8_WAIT_L(0); PG8_MMA(1, 0, At, B0); PG8_BAR; PG8_SCHED;
            PG8_STAGE(PG8_SB(0, 1), b2 + hstep, voffB);
            PG8_WAIT_V(6); PG8_BAR; PG8_MMA(1, 1, At, B1); PG8_BAR;
            PG8_LDB(B0, 1, 0); PG8_SCHED; PG8_LDA(At, 1, 0); PG8_STAGE(PG8_SA(0, 1), a2 + hstep, voffA);
            PG8_WAIT_L(8); PG8_BAR; PG8_WAIT_L(0); PG8_MMA(0, 0, At, B0); PG8_BAR; PG8_SCHED;
            PG8_LDB(B1, 1, 1); PG8_STAGE(PG8_SB(1, 0), b3, voffB);
            PG8_BAR; PG8_WAIT_L(0); PG8_MMA(0, 1, At, B1); PG8_BAR;
            PG8_LDA(At, 1, 1); PG8_STAGE(PG8_SA(1, 0), a3, voffA);
            PG8_BAR; PG8_WAIT_L(0); PG8_MMA(1, 0, At, B0); PG8_BAR; PG8_SCHED;
            PG8_STAGE(PG8_SB(1, 1), b3 + hstep, voffB);
            PG8_WAIT_V(6); PG8_BAR; PG8_MMA(1, 1, At, B1); PG8_BAR;
        }
        PG8_STAMP();
        if constexpr (!Epi::AFTER_DRAIN) { E(acc, cur, wr, wc, fr, fq); S.done(cur); }
        PG8_STAMP();
        if (!has_next) break;
#pragma unroll
        for (int a = 0; a < 2; ++a)
#pragma unroll
            for (int b = 0; b < 2; ++b)
#pragma unroll
                for (int m = 0; m < 4; ++m)
#pragma unroll
                    for (int n = 0; n < 2; ++n) acc[a][b][m][n] = (f32x4){0.f, 0.f, 0.f, 0.f};
        cur = nxt; cA = nA; cB = nB; ++ui;
    }
    PG8_WAIT_V(0);
    if (wr == 0) PG8_BAR;
    PG8_BAR;
    if constexpr (Epi::AFTER_DRAIN) { E.fused(acc, cur, wr, wc, fr, fq, lds, wid, lane); S.done(cur); }
    PG8_STAMP();
    if (STAMP && wid == 0) { stamps[lane] = lane < nts ? (((unsigned long long)(unsigned)ts_hi << 32) | (unsigned)ts_lo) : 0ull;
        if (lane == 62) stamps[62] = rt_entry; if (lane == 63) stamps[63] = (unsigned long long)wall_clock64(); }
#undef PG8_STAMP
#undef PG8_SA
#undef PG8_SB
#undef PG8_STAGE
#undef PG8_LDA
#undef PG8_LDB
#undef PG8_MMA
#undef PG8_WAIT_V
#undef PG8_WAIT_L
#undef PG8_BAR
#undef PG8_SCHED
}
}

#define LAS __attribute__((address_space(3)))
using pg8::bf16_t; using pg8::bf16x8; using pg8::f32x4; using pg8::u32x4;
typedef unsigned u32x2 __attribute__((ext_vector_type(2)));
typedef short s16x4 __attribute__((ext_vector_type(4)));

constexpr int T_ALL = 17408, T_P = 16384, DM = 1024, NPROJ = 4096, NIN = 4104, NUP = 5632, DFF = 2816;
constexpr int LDS_BYTES = 131072 + 4096;
constexpr int MISC_OFF = 131072;
constexpr size_t MiB = (size_t)1 << 20;
constexpr size_t al256(size_t x) { return (x + 255) & ~(size_t)255; }
constexpr size_t WS_WIN = 0, WS_WOUT = 8 * MiB, WS_WUP = 10 * MiB, WS_WDOWN = 21 * MiB;
constexpr size_t WS_GATES = 27 * MiB;
constexpr size_t WS_RC = al256(WS_GATES + (size_t)T_ALL * 8 * 4);
constexpr size_t WS_RS = al256(WS_RC + (size_t)2056 * 64 * 4);
constexpr size_t WS_GA = al256(WS_RS + (size_t)2056 * 64 * 4);
constexpr size_t WS_GCM = al256(WS_GA + (size_t)T_ALL * 4 * 4);
constexpr size_t WS_GB = al256(WS_GCM + (size_t)T_ALL * 4 * 4);
constexpr size_t WS_CHK = al256(WS_GB + (size_t)T_ALL * 4 * 4);
constexpr size_t WS_SMALL_END = al256(WS_CHK + 1024 * 2 * 4);
static_assert(WS_SMALL_END <= 30 * MiB, "small region overflow");
constexpr size_t WS_X1 = 30 * MiB;
constexpr size_t WS_H = WS_X1, WS_LST = WS_X1 + 34 * MiB, WS_MIXIN = WS_X1;
constexpr size_t WS_PROJ = 98 * MiB;
constexpr size_t WS_MIXO = 98 * MiB;
constexpr size_t WS_ACT = 98 * MiB;
constexpr size_t WS_EDGE = 192 * MiB, WS_HEAD = 204 * MiB;
constexpr size_t WS_H2 = 222 * MiB;
constexpr int LST_TILE = 136 * 128;
constexpr size_t O_Y = 0, O_SP = 17825792, O_SS = 18350080, O_CP = 26738688, O_CS = 27262976, O_NP = 35651584, O_NS = 35655680, O_MP = 35721216, O_MS = 35721248, O_BP = 35721760, O_BS = 35811872;

struct Args { const float* in[20]; float* out; unsigned char* ws; };

__device__ __forceinline__ float bf2f(unsigned short b) { return __uint_as_float(((unsigned)b) << 16); }
__device__ __forceinline__ unsigned pk2(float lo, float hi) { return pg8::cvt_pk_bf16(lo, hi); }
__device__ __forceinline__ float wave_sum(float v) {
#pragma unroll
    for (int o = 32; o >= 1; o >>= 1) v += __shfl_xor(v, o);
    return v; }
__device__ __forceinline__ const float* xrow(const Args& A, int r) { return r < T_P ? A.in[0] + (size_t)r * DM : A.in[1] + (size_t)(r - T_P) * DM; }
__device__ __forceinline__ float sigmoidf_(float x) { return 1.0f / (1.0f + __expf(-x)); }

__device__ __forceinline__ unsigned off_b(unsigned row, unsigned ch) { return 256u * row + 16u * (ch ^ (((row & 3) << 2) | ((row >> 2) & 3))); }
__device__ __forceinline__ unsigned rr_base(int lane) { return off_b(lane & 15, lane >> 4); }
__device__ __forceinline__ bf16x8 row_read(LAS unsigned char* tile, unsigned rr0, int rb, int s) { return *(const LAS bf16x8*)(tile + ((rr0 ^ (unsigned)(s << 6)) + 4096u * (unsigned)rb)); }
__device__ __forceinline__ unsigned tr_base_std(int lane, int t) { const unsigned g = lane >> 4, q = (lane & 15) >> 2, p = lane & 3; return 256u * (8 * g + 4 * t + q) + 16u * ((p >> 1) ^ ((q << 2) | ((2 * g + t) & 3))) + 8u * (p & 1); }
__device__ __forceinline__ unsigned tr_base_perm(int lane) { const unsigned g = lane >> 4, q = (lane & 15) >> 2, p = lane & 3; return 256u * (4 * g + q) + 16u * ((p >> 1) ^ ((q << 2) | g)) + 8u * (p & 1); }
__device__ __forceinline__ bf16x8 tr_frag(unsigned a0, unsigned a1) {
    s16x4 r0, r1;
    asm volatile("ds_read_b64_tr_b16 %0, %2\n\tds_read_b64_tr_b16 %1, %3\n\ts_waitcnt lgkmcnt(0)" : "=&v"(r0), "=&v"(r1) : "v"(a0), "v"(a1) : "memory");
    return __builtin_shufflevector(r0, r1, 0, 1, 2, 3, 4, 5, 6, 7); }
__device__ __forceinline__ void tr_frag2(unsigned a0, unsigned a1, unsigned a2, unsigned a3, bf16x8& f0, bf16x8& f1) {
    s16x4 r0, r1, r2, r3;
    asm volatile("ds_read_b64_tr_b16 %0, %4\n\tds_read_b64_tr_b16 %1, %5\n\tds_read_b64_tr_b16 %2, %6\n\tds_read_b64_tr_b16 %3, %7\n\ts_waitcnt lgkmcnt(0)"
                 : "=&v"(r0), "=&v"(r1), "=&v"(r2), "=&v"(r3) : "v"(a0), "v"(a1), "v"(a2), "v"(a3) : "memory");
    f0 = __builtin_shufflevector(r0, r1, 0, 1, 2, 3, 4, 5, 6, 7); f1 = __builtin_shufflevector(r2, r3, 0, 1, 2, 3, 4, 5, 6, 7); }
#define OPAQUE(x) asm volatile("" : "+v"(x))
#define MFMA16(a, b, c) __builtin_amdgcn_mfma_f32_16x16x32_bf16((a), (b), (c), 0, 0, 0)

template <bool ROT>
__device__ __forceinline__ void fill_bf16(LAS unsigned char* tile, const bf16_t* src, int ld, int nvalid, int ntotal, int pos0, const float* RC, const float* RS, float scale, const LAS float* wrow) {
    for (int idx = threadIdx.x; idx < ntotal * 8; idx += 512) {
        const int row = idx >> 3, ch = idx & 7;
        u32x4 lo = {0u, 0u, 0u, 0u}, hi = {0u, 0u, 0u, 0u};
        if (row < nvalid) {
            const bf16_t* p = src + (size_t)row * ld + ch * 8; lo = *(const u32x4*)p; hi = *(const u32x4*)(p + 64);
            if (ROT || scale != 1.0f || wrow != nullptr) {
                float a[8], b[8];
#pragma unroll
                for (int j = 0; j < 4; ++j) { a[2 * j] = __uint_as_float(lo[j] << 16); a[2 * j + 1] = __uint_as_float(lo[j] & 0xffff0000u); b[2 * j] = __uint_as_float(hi[j] << 16); b[2 * j + 1] = __uint_as_float(hi[j] & 0xffff0000u); }
                if (ROT) {
                    const float* cp = RC + (size_t)(pos0 + row) * 64 + ch * 8; const float* sp = RS + (size_t)(pos0 + row) * 64 + ch * 8;
                    const f32x4 c0 = *(const f32x4*)cp, c1 = *(const f32x4*)(cp + 4), s0 = *(const f32x4*)sp, s1 = *(const f32x4*)(sp + 4);
#pragma unroll
                    for (int j = 0; j < 8; ++j) { const float cc = j < 4 ? c0[j & 3] : c1[j & 3], ss = j < 4 ? s0[j & 3] : s1[j & 3]; const float x1 = a[j], x2 = b[j]; a[j] = x1 * cc - x2 * ss; b[j] = x1 * ss + x2 * cc; }
                }
                const float m = scale * (wrow != nullptr ? wrow[row] : 1.0f);
#pragma unroll
                for (int j = 0; j < 4; ++j) { lo[j] = pk2(a[2 * j] * m, a[2 * j + 1] * m); hi[j] = pk2(b[2 * j] * m, b[2 * j + 1] * m); }
            }
        }
        *(LAS u32x4*)(tile + off_b(row, ch)) = lo; *(LAS u32x4*)(tile + off_b(row, ch + 8)) = hi;
    }
}
__device__ __forceinline__ void fill_from_f32(LAS unsigned char* tile, const float* src) {
    for (int idx = threadIdx.x; idx < 2048; idx += 512) { const int row = idx >> 4, ch = idx & 15; const float* p = src + row * 128 + ch * 8;
        const f32x4 a = *(const f32x4*)p, b = *(const f32x4*)(p + 4); u32x4 w; w[0] = pk2(a[0], a[1]); w[1] = pk2(a[2], a[3]); w[2] = pk2(b[0], b[1]); w[3] = pk2(b[2], b[3]);
        *(LAS u32x4*)(tile + off_b(row, ch)) = w; }
}
__device__ __forceinline__ void fill_copy(LAS unsigned char* tile, const bf16_t* src) {
    for (int idx = threadIdx.x; idx < 2048; idx += 512) { const int row = idx >> 4, ch = idx & 15; *(LAS u32x4*)(tile + off_b(row, ch)) = *(const u32x4*)(src + row * 128 + ch * 8); }
}

template <int NKS, bool NROW>
__device__ __forceinline__ void local_prod(f32x4 (&acc)[9], unsigned kimg, unsigned vimg, const LAS float* wrow, int w, int lane) {
    const int g = lane >> 4, i = lane & 15;
    const unsigned tb0 = tr_base_std(lane, 0), tb1 = tr_base_std(lane, 1);
#pragma unroll
    for (int ks = 0; ks < NKS; ++ks) {
        unsigned b0_ = tb0, b1_ = tb1; OPAQUE(b0_); OPAQUE(b1_);
        const unsigned ko = kimg + 8192u * ks, vo = vimg + 8192u * ks;
        const bf16x8 a = tr_frag((b0_ ^ ((unsigned)w << 5)) + ko, (b1_ ^ ((unsigned)w << 5)) + ko);
#pragma unroll
        for (int c = 0; c < 8; c += 2) { bf16x8 f0, f1; tr_frag2((b0_ ^ (unsigned)(c << 5)) + vo, (b1_ ^ (unsigned)(c << 5)) + vo, (b0_ ^ (unsigned)((c + 1) << 5)) + vo, (b1_ ^ (unsigned)((c + 1) << 5)) + vo, f0, f1);
            acc[c] = MFMA16(a, f0, acc[c]); acc[c + 1] = MFMA16(a, f1, acc[c + 1]); }
        if (NROW) {
            const int rb0 = 32 * ks + 8 * g;
            const f32x4 w0 = *(const LAS f32x4*)(wrow + rb0), w1 = *(const LAS f32x4*)(wrow + rb0 + 4);
            u32x4 bw; bw[0] = pk2(w0[0], w0[1]); bw[1] = pk2(w0[2], w0[3]); bw[2] = pk2(w1[0], w1[1]); bw[3] = pk2(w1[2], w1[3]);
            if (i != 0) bw = (u32x4){0u, 0u, 0u, 0u};
            acc[8] = MFMA16(a, __builtin_bit_cast(bf16x8, bw), acc[8]);
        }
    }
}

template <int GRP, bool GTR>
__device__ __forceinline__ void out_wave(const Args& A, LAS unsigned char* qimg, LAS unsigned char* kimg, LAS unsigned char* vimg, LAS unsigned char* gimg, const LAS float* misc,
                                         float m_prev, float lg2g, int w, int lane, int t0, int nvalid, int h) {
    const int i = lane & 15, g = lane >> 4;
    const unsigned vbase = (unsigned)(size_t)vimg, gbase = (unsigned)(size_t)gimg;
    const LAS float* a_s = misc + 128; const LAS float* cmx = misc + 256; const LAS float* bbs = misc + 384; const LAS unsigned char* nl = (const LAS unsigned char*)(misc + 512);
    const unsigned rr0 = rr_base(lane);
    bf16x8 qf[4];
#pragma unroll
    for (int kd = 0; kd < 4; ++kd) qf[kd] = row_read(qimg, rr0, w, kd);
    f32x4 pT[8];
#pragma unroll
    for (int c = 0; c < 8; ++c) pT[c] = (f32x4){0.f, 0.f, 0.f, 0.f};
#pragma unroll
    for (int c = 0; c < 8; ++c) if (c <= w) {
#pragma unroll
        for (int kd = 0; kd < 4; ++kd) pT[c] = MFMA16(row_read(kimg, rr0, c, kd), qf[kd], pT[c]);
    }
    const int t = 16 * w + i;
    const float Mt_i = GRP ? fmaxf(m_prev, cmx[t]) : 0.f;
#pragma unroll
    for (int c = 0; c < 8; ++c) if (c <= w) {
        f32x4 av = (f32x4){0.f, 0.f, 0.f, 0.f}; if (GRP) av = *(const LAS f32x4*)(a_s + 16 * c + 4 * g);
#pragma unroll
        for (int r = 0; r < 4; ++r) { const int s = 16 * c + 4 * g + r; float wg;
            if (GRP) wg = __expf(av[r] - Mt_i); else wg = exp2f((float)(t - s) * lg2g);
            pT[c][r] = (s <= t) ? pT[c][r] * wg : 0.f; }
    }
    f32x4 acc[9];
#pragma unroll
    for (int c = 0; c < 9; ++c) acc[c] = (f32x4){0.f, 0.f, 0.f, 0.f};
#pragma unroll
    for (int kd = 0; kd < 4; ++kd) {
#pragma unroll
        for (int cv = 0; cv < 8; cv += 2) {
            bf16x8 b0, b1;
            if (GTR) { unsigned x0 = tr_base_std(lane, 0), x1 = tr_base_std(lane, 1); OPAQUE(x0); OPAQUE(x1); const unsigned go = gbase + 8192u * kd;
                tr_frag2((x0 ^ (unsigned)(cv << 5)) + go, (x1 ^ (unsigned)(cv << 5)) + go, (x0 ^ (unsigned)((cv + 1) << 5)) + go, (x1 ^ (unsigned)((cv + 1) << 5)) + go, b0, b1); }
            else { b0 = row_read(gimg, rr0, cv, kd); b1 = row_read(gimg, rr0, cv + 1, kd); }
            acc[cv] = MFMA16(qf[kd], b0, acc[cv]); acc[cv + 1] = MFMA16(qf[kd], b1, acc[cv + 1]);
        }
        if (GRP) { u32x4 bn = *(const LAS u32x4*)(nl + (32 * kd + 8 * g) * 2); if (i != 0) bn = (u32x4){0u, 0u, 0u, 0u}; acc[8] = MFMA16(qf[kd], __builtin_bit_cast(bf16x8, bn), acc[8]); }
    }
    float Mt_r[4];
#pragma unroll
    for (int r = 0; r < 4; ++r) { const int tl = 16 * w + 4 * g + r; float sc;
        if (GRP) { Mt_r[r] = fmaxf(m_prev, cmx[tl]); sc = __expf(m_prev - Mt_r[r]); } else { Mt_r[r] = 0.f; sc = exp2f((float)(tl + 1) * lg2g); }
#pragma unroll
        for (int c = 0; c < 9; ++c) acc[c][r] *= sc; }
    u32x4 ones = (u32x4){0x3f803f80u, 0x3f803f80u, 0x3f803f80u, 0x3f803f80u}; if (i != 0) ones = (u32x4){0u, 0u, 0u, 0u};
#pragma unroll
    for (int ks = 0; ks < 4; ++ks) if (2 * ks <= w) {
        u32x4 pa; pa[0] = pk2(pT[2 * ks][0], pT[2 * ks][1]); pa[1] = pk2(pT[2 * ks][2], pT[2 * ks][3]); pa[2] = pk2(pT[2 * ks + 1][0], pT[2 * ks + 1][1]); pa[3] = pk2(pT[2 * ks + 1][2], pT[2 * ks + 1][3]);
        const bf16x8 af = __builtin_bit_cast(bf16x8, pa);
        unsigned tp = tr_base_perm(lane); OPAQUE(tp); const unsigned vo = vbase + 8192u * ks;
#pragma unroll
        for (int cv = 0; cv < 8; cv += 2) { bf16x8 b0, b1; const unsigned y0 = (tp ^ (unsigned)(cv << 5)) + vo, y1 = (tp ^ (unsigned)((cv + 1) << 5)) + vo;
            tr_frag2(y0, y0 + 4096u, y1, y1 + 4096u, b0, b1); acc[cv] = MFMA16(af, b0, acc[cv]); acc[cv + 1] = MFMA16(af, b1, acc[cv + 1]); }
        if (GRP) acc[8] = MFMA16(af, __builtin_bit_cast(bf16x8, ones), acc[8]);
    }
    const float* gain = (GRP ? A.in[11] : A.in[10]) + h * 128;
    const bf16_t* PROJ = (const bf16_t*)(A.ws + WS_PROJ); bf16_t* MIXIN = (bf16_t*)(A.ws + WS_MIXIN);
    const int gcol = (GRP ? 3584 : 1536) + h * 128;
    float gn[8];
#pragma unroll
    for (int cv = 0; cv < 8; ++cv) gn[cv] = gain[16 * cv + i];
#pragma unroll
    for (int r = 0; r < 4; ++r) {
        const int tl = 16 * w + 4 * g + r;
        float hv[8];
        float inv = 1.0f;
        if (GRP) { const float dd = __shfl(acc[8][r], lane & 48); const float mt = bbs[tl] + Mt_r[r]; inv = 1.0f / fmaxf(fabsf(dd), __expf(-mt)); }
        float s1 = 0.f;
#pragma unroll
        for (int cv = 0; cv < 8; ++cv) { hv[cv] = acc[cv][r] * inv; s1 += hv[cv]; }
        s1 += __shfl_xor(s1, 1); s1 += __shfl_xor(s1, 2); s1 += __shfl_xor(s1, 4); s1 += __shfl_xor(s1, 8);
        const float mu = s1 * (1.0f / 128.0f); float s2 = 0.f;
#pragma unroll
        for (int cv = 0; cv < 8; ++cv) { const float d = hv[cv] - mu; s2 += d * d; }
        s2 += __shfl_xor(s2, 1); s2 += __shfl_xor(s2, 2); s2 += __shfl_xor(s2, 4); s2 += __shfl_xor(s2, 8);
        const float rstd = rsqrtf(s2 * (1.0f / 128.0f) + 1e-6f);
        if (tl < nvalid) {
            const bf16_t* gp = PROJ + (size_t)(t0 + tl) * NPROJ + gcol + i; bf16_t* op = MIXIN + (size_t)(t0 + tl) * DM + GRP * 512 + h * 128 + i;
#pragma unroll
            for (int cv = 0; cv < 8; ++cv) { const float gv = bf2f(gp[16 * cv]); const float sg = sigmoidf_(gv); const float act = GRP ? sg : gv * sg;
                const float y = (hv[cv] - mu) * rstd * gn[cv] * act; op[16 * cv] = (bf16_t)(pk2(y, y) & 0xffffu); }
        }
    }
}

__device__ void phase_convert_weights(const Args& A, LAS unsigned char* lds) {
    LAS float* tile = (LAS float*)lds;
    const int tid = threadIdx.x;
    constexpr int NT_IN = 64 * 16, NT_OUT = 16 * 16, NT_UP = 88 * 16, NT_DOWN = 16 * 44;
    for (int t = blockIdx.x; t < NT_IN + NT_OUT + NT_UP + NT_DOWN; t += gridDim.x) {
        const float* W; bf16_t* Bt; int K, ld, which, tt = t;
        if (tt < NT_IN) { which = 0; W = A.in[8]; ld = NIN; K = 1024; Bt = (bf16_t*)(A.ws + WS_WIN); }
        else if ((tt -= NT_IN) < NT_OUT) { which = 1; W = A.in[12]; ld = 1024; K = 1024; Bt = (bf16_t*)(A.ws + WS_WOUT); }
        else if ((tt -= NT_OUT) < NT_UP) { which = 2; W = A.in[15]; ld = NUP; K = 1024; Bt = (bf16_t*)(A.ws + WS_WUP); }
        else { tt -= NT_UP; which = 3; W = A.in[18]; ld = 1024; K = 2816; Bt = (bf16_t*)(A.ws + WS_WDOWN); }
        const int ktiles = K / 64, nt = tt / ktiles, kt = tt % ktiles, n0 = nt * 64, k0 = kt * 64;
        int c0 = n0; if (which == 2) { const int pn = n0 >> 8, bj = (n0 >> 7) & 1, ii = n0 & 127; c0 = bj * DFF + 128 * pn + ii; }
        { const int k = tid >> 3, n8 = (tid & 7) * 8; const float* p = W + (size_t)(k0 + k) * ld + c0 + n8;
          const f32x4 a = *(const f32x4*)p, b = *(const f32x4*)(p + 4); LAS float* d = tile + k * 65 + n8;
          d[0] = a[0]; d[1] = a[1]; d[2] = a[2]; d[3] = a[3]; d[4] = b[0]; d[5] = b[1]; d[6] = b[2]; d[7] = b[3]; }
        __syncthreads();
        { const int n = tid >> 3, k8 = (tid & 7) * 8; float v[8];
#pragma unroll
          for (int j = 0; j < 8; ++j) v[j] = tile[(k8 + j) * 65 + n];
          u32x4 w; w[0] = pk2(v[0], v[1]); w[1] = pk2(v[2], v[3]); w[2] = pk2(v[4], v[5]); w[3] = pk2(v[6], v[7]);
          *(u32x4*)(Bt + (size_t)(n0 + n) * K + k0 + k8) = w; }
        __syncthreads();
    }
}

__device__ void phase_prep_rows(const Args& A) {
    const int lane = threadIdx.x & 63, wid = threadIdx.x >> 6;
    bf16_t* H = (bf16_t*)(A.ws + WS_H); float* GATES = (float*)(A.ws + WS_GATES);
    for (int r = blockIdx.x * 8 + wid; r < T_ALL; r += gridDim.x * 8) {
        const float* x = xrow(A, r); f32x4 v[4]; float ss = 0.f;
#pragma unroll
        for (int q = 0; q < 4; ++q) { v[q] = *(const f32x4*)(x + q * 256 + lane * 4); ss += v[q][0] * v[q][0] + v[q][1] * v[q][1] + v[q][2] * v[q][2] + v[q][3] * v[q][3]; }
        ss = wave_sum(ss); const float rstd = rsqrtf(ss * (1.0f / 1024.0f) + 1e-6f);
        float g8[8];
#pragma unroll
        for (int j = 0; j < 8; ++j) g8[j] = 0.f;
#pragma unroll
        for (int q = 0; q < 4; ++q) {
            const f32x4 gn = *(const f32x4*)(A.in[7] + q * 256 + lane * 4); const f32x4 hh = v[q] * rstd * gn;
            u32x2 w; w[0] = pk2(hh[0], hh[1]); w[1] = pk2(hh[2], hh[3]); *(u32x2*)(H + (size_t)r * DM + q * 256 + lane * 4) = w;
#pragma unroll
            for (int e = 0; e < 4; ++e) { const float* wg = A.in[8] + (size_t)(q * 256 + lane * 4 + e) * NIN + 4096; const f32x4 w0 = *(const f32x4*)wg, w1 = *(const f32x4*)(wg + 4);
#pragma unroll
                for (int j = 0; j < 4; ++j) { g8[j] += hh[e] * w0[j]; g8[4 + j] += hh[e] * w1[j]; } }
        }
        float outv = 0.f;
#pragma unroll
        for (int j = 0; j < 8; ++j) { const float s = wave_sum(g8[j]); if (lane == j) outv = s; }
        if (lane < 8) GATES[(size_t)r * 8 + lane] = outv + A.in[9][lane];
    }
}

__device__ void phase_rope_table(const Args& A) {
    float* RC = (float*)(A.ws + WS_RC); float* RS = (float*)(A.ws + WS_RS);
    for (int idx = blockIdx.x * 512 + threadIdx.x; idx < 2056 * 64; idx += gridDim.x * 512) {
        const int p = idx >> 6, i = idx & 63; const double pos = p < 2048 ? (double)p : (double)(16384 + (p - 2048));
        const double freq = exp2(-(double)i * (13.287712379549449 / 64.0)); double rev = pos * freq * 0.15915494309189535; rev -= rint(rev);
        const float fr = (float)rev; RC[idx] = __builtin_amdgcn_cosf(fr); RS[idx] = __builtin_amdgcn_sinf(fr);
    }
}

__device__ __forceinline__ float logsig(float f) { return f > 0.f ? -log1pf(__expf(-f)) : f - log1pf(__expf(f)); }
__device__ void phase_gate_scan(const Args& A) {
    const int lane = threadIdx.x & 63, wid = threadIdx.x >> 6;
    const float* GATES = (const float*)(A.ws + WS_GATES); float* GA = (float*)(A.ws + WS_GA); float* GCM = (float*)(A.ws + WS_GCM); float* GB = (float*)(A.ws + WS_GB); float* CHK = (float*)(A.ws + WS_CHK);
    for (int u = blockIdx.x * 8 + wid; u < 1024; u += gridDim.x * 8) {
        int t0, len, h;
        if (u < 512) { const int b = u >> 6, c = u & 15; h = (u >> 4) & 3; t0 = b * 2048 + c * 128; len = 128; } else { const int v = u - 512, b = v >> 2; h = v & 3; t0 = T_P + b * 8; len = 8; }
        const int s0 = 2 * lane, s1 = s0 + 1; const bool v0 = s0 < len, v1 = s1 < len;
        float i0 = 0.f, i1 = 0.f, l0 = 0.f, l1 = 0.f;
        if (v0) { i0 = GATES[(size_t)(t0 + s0) * 8 + h]; l0 = logsig(GATES[(size_t)(t0 + s0) * 8 + 4 + h]); }
        if (v1) { i1 = GATES[(size_t)(t0 + s1) * 8 + h]; l1 = logsig(GATES[(size_t)(t0 + s1) * 8 + 4 + h]); }
        float x = l0 + l1;
#pragma unroll
        for (int o = 1; o < 64; o <<= 1) { const float y = __shfl_up(x, o); if (lane >= o) x += y; }
        const float ex = x - (l0 + l1), b0 = ex + l0, b1 = b0 + l1;
        const float a0 = v0 ? i0 - b0 : -3e38f, a1 = v1 ? i1 - b1 : -3e38f;
        float mx = fmaxf(a0, a1);
#pragma unroll
        for (int o = 1; o < 64; o <<= 1) { const float y = __shfl_up(mx, o); if (lane >= o) mx = fmaxf(mx, y); }
        float pm = __shfl_up(mx, 1); if (lane == 0) pm = -3e38f;
        const float c0 = fmaxf(pm, a0), c1 = fmaxf(c0, a1);
        if (v0) { const size_t o = (size_t)(t0 + s0) * 4 + h; GB[o] = b0; GA[o] = a0; GCM[o] = c0; }
        if (v1) { const size_t o = (size_t)(t0 + s1) * 4 + h; GB[o] = b1; GA[o] = a1; GCM[o] = c1; }
        const float Btot = __shfl(x, 63), Amax = __shfl(mx, 63);
        if (lane == 0) { CHK[u * 2] = Btot; CHK[u * 2 + 1] = Amax; }
    }
}

__device__ void local_unit(const Args& A, LAS unsigned char* lds, int seq, int c) {
    const int tid = threadIdx.x, lane = tid & 63, w = __builtin_amdgcn_readfirstlane(tid >> 6), g = lane >> 4, i = lane & 15;
    const int grp = seq >> 5, b = (seq >> 2) & 7, h = seq & 3, t0 = b * 2048 + c * 128;
    LAS float* misc = (LAS float*)(lds + MISC_OFF);
    const float lg2g = log2f(1.0f - exp2f(-5.0f - (float)h));
    const float* GA = (const float*)(A.ws + WS_GA); const float* CHK = (const float*)(A.ws + WS_CHK);
    if (tid < 128) { float wv; if (grp == 0) wv = exp2f((float)(127 - tid) * lg2g); else { const float Amax = CHK[((seq & 31) * 16 + c) * 2 + 1]; wv = __expf(GA[(size_t)(t0 + tid) * 4 + h] - Amax); } misc[tid] = wv; }
    __syncthreads();
    const bf16_t* PROJ = (const bf16_t*)(A.ws + WS_PROJ) + (size_t)t0 * NPROJ;
    const float* RC = (const float*)(A.ws + WS_RC); const float* RS = (const float*)(A.ws + WS_RS);
    LAS unsigned char* T0 = lds; LAS unsigned char* T1 = lds + 32768;
    const float kscale = 0.08838834764831845f;
    if (grp == 0) fill_bf16<true>(T0, PROJ + 512 + h * 128, NPROJ, 128, 128, c * 128, RC, RS, kscale, nullptr);
    else fill_bf16<false>(T0, PROJ + 2560 + h * 128, NPROJ, 128, 128, 0, RC, RS, kscale, nullptr);
    fill_bf16<false>(T1, PROJ + (grp ? 3072 : 1024) + h * 128, NPROJ, 128, 128, 0, RC, RS, 1.0f, misc);
    __syncthreads();
    f32x4 acc[9];
#pragma unroll
    for (int q = 0; q < 9; ++q) acc[q] = (f32x4){0.f, 0.f, 0.f, 0.f};
    if (grp) local_prod<4, true>(acc, (unsigned)(size_t)T0, (unsigned)(size_t)T1, misc, w, lane); else local_prod<4, false>(acc, (unsigned)(size_t)T0, (unsigned)(size_t)T1, misc, w, lane);
    bf16_t* L = (bf16_t*)(A.ws + WS_LST) + (size_t)(seq * 16 + c) * LST_TILE;
#pragma unroll
    for (int cc = 0; cc < 8; ++cc) { u32x2 o; o[0] = pk2(acc[cc][0], acc[cc][1]); o[1] = pk2(acc[cc][2], acc[cc][3]); *(u32x2*)(L + (16 * cc + i) * 128 + 16 * w + 4 * g) = o; }
    if (grp && i == 0) { u32x2 o; o[0] = pk2(acc[8][0], acc[8][1]); o[1] = pk2(acc[8][2], acc[8][3]); *(u32x2*)(L + 128 * 128 + 16 * w + 4 * g) = o; }
    __syncthreads();
}

__device__ void sample_unit(const Args& A, LAS unsigned char* lds, int grp, int b, int h) {
    const int tid = threadIdx.x, lane = tid & 63, w = __builtin_amdgcn_readfirstlane(tid >> 6), g = lane >> 4, i = lane & 15;
    const int t0 = T_P + b * 8, bh = b * 4 + h;
    LAS float* misc = (LAS float*)(lds + MISC_OFF);
    const float lg2g = log2f(1.0f - exp2f(-5.0f - (float)h));
    const float* GA = (const float*)(A.ws + WS_GA); const float* GCM = (const float*)(A.ws + WS_GCM); const float* GB = (const float*)(A.ws + WS_GB); const float* CHK = (const float*)(A.ws + WS_CHK);
    float m0 = 0.f, Btot = 0.f, Mlast = 0.f;
    if (grp) { m0 = A.in[5][bh]; Btot = CHK[(512 + bh) * 2]; Mlast = fmaxf(m0, CHK[(512 + bh) * 2 + 1]); }
    if (tid < 128) {
        float wv = 0.f, av = -3e38f, cv = 0.f, bv = 0.f;
        if (tid < 8) { if (grp) { const size_t o = (size_t)(t0 + tid) * 4 + h; av = GA[o]; cv = GCM[o]; bv = GB[o]; wv = __expf(av - Mlast); } else wv = exp2f((float)(7 - tid) * lg2g); }
        misc[tid] = wv; misc[128 + tid] = av; misc[256 + tid] = cv; misc[384 + tid] = bv;
        if (tid < 64) { unsigned nn = 0u; if (grp) nn = pk2(A.in[4][bh * 128 + 2 * tid], A.in[4][bh * 128 + 2 * tid + 1]); ((LAS unsigned*)(misc + 512))[tid] = nn; }
    }
    __syncthreads();
    const bf16_t* PROJ = (const bf16_t*)(A.ws + WS_PROJ) + (size_t)t0 * NPROJ;
    const float* RC = (const float*)(A.ws + WS_RC); const float* RS = (const float*)(A.ws + WS_RS);
    LAS unsigned char* TQ = lds; LAS unsigned char* TK = lds + 8192; LAS unsigned char* TV = lds + 16384; LAS unsigned char* TW = lds + 24576; LAS unsigned char* TG = lds + 32768;
    const float kscale = 0.08838834764831845f;
    const int qc = (grp ? 2048 : 0) + h * 128, kc = (grp ? 2560 : 512) + h * 128, vc = (grp ? 3072 : 1024) + h * 128;
    if (grp == 0) { fill_bf16<true>(TQ, PROJ + qc, NPROJ, 8, 32, 2048, RC, RS, 1.0f, nullptr); fill_bf16<true>(TK, PROJ + kc, NPROJ, 8, 32, 2048, RC, RS, kscale, nullptr); }
    else { fill_bf16<false>(TQ, PROJ + qc, NPROJ, 8, 32, 0, RC, RS, 1.0f, nullptr); fill_bf16<false>(TK, PROJ + kc, NPROJ, 8, 32, 0, RC, RS, kscale, nullptr); }
    fill_bf16<false>(TV, PROJ + vc, NPROJ, 8, 32, 0, RC, RS, 1.0f, nullptr);
    fill_bf16<false>(TW, PROJ + vc, NPROJ, 8, 32, 0, RC, RS, 1.0f, misc);
    const float* S0 = (grp ? A.in[3] : A.in[2]) + (size_t)bh * 16384;
    fill_from_f32(TG, S0);
    __syncthreads();
    if (w == 0) { if (grp) out_wave<1, false>(A, TQ, TK, TV, TG, misc, m0, lg2g, 0, lane, t0, 8, h); else out_wave<0, true>(A, TQ, TK, TV, TG, misc, 0.f, lg2g, 0, lane, t0, 8, h); }
    f32x4 acc[9];
#pragma unroll
    for (int q = 0; q < 9; ++q) acc[q] = (f32x4){0.f, 0.f, 0.f, 0.f};
    if (grp) local_prod<1, true>(acc, (unsigned)(size_t)TK, (unsigned)(size_t)TW, misc, w, lane); else local_prod<1, false>(acc, (unsigned)(size_t)TK, (unsigned)(size_t)TW, misc, w, lane);
    if (grp == 0) {
        const float dec = exp2f(8.0f * lg2g); float* So = A.out + O_SS + (size_t)bh * 16384;
#pragma unroll
        for (int cv = 0; cv < 8; ++cv)
#pragma unroll
            for (int r = 0; r < 4; ++r) { const int idx = (16 * w + 4 * g + r) * 128 + 16 * cv + i; So[idx] = dec * S0[idx] + acc[cv][r]; }
    } else {
        const float dec = __expf(m0 - Mlast); float* Co = A.out + O_CS + (size_t)bh * 16384;
#pragma unroll
        for (int cv = 0; cv < 8; ++cv) { const int idx = (16 * cv + i) * 128 + 16 * w + 4 * g; const f32x4 c0 = *(const f32x4*)(S0 + idx); *(f32x4*)(Co + idx) = c0 * dec + acc[cv]; }
        if (i == 0) { const int d = 16 * w + 4 * g; const f32x4 n0 = *(const f32x4*)(A.in[4] + bh * 128 + d); *(f32x4*)(A.out + O_NS + bh * 128 + d) = n0 * dec + acc[8]; }
        if (tid == 0) A.out[O_MS + bh] = Btot + Mlast;
    }
    __syncthreads();
}

__device__ void phase_local_and_sample(const Args& A, LAS unsigned char* lds) {
    for (int u = blockIdx.x; u < 2048; u += gridDim.x) {
        if (u < 1024) local_unit(A, lds, u >> 4, u & 15);
        else { const int v = u - 1024; sample_unit(A, lds, v >> 9, (v >> 2) & 127, v & 3); }
    }
}

__device__ void phase_scan(const Args& A) {
    bf16_t* LST = (bf16_t*)(A.ws + WS_LST); const float* CHK = (const float*)(A.ws + WS_CHK);
    for (int idx = blockIdx.x * 512 + threadIdx.x; idx < 64 * 4128; idx += gridDim.x * 512) {
        const int seq = idx / 4128, e = idx % 4128, row = e >> 5, d4 = (e & 31) * 4, grp = seq >> 5, b = (seq >> 2) & 7, h = seq & 3, bh = b * 4 + h;
        if (grp == 0 && row == 128) continue;
        bf16_t* base = LST + (size_t)seq * 16 * LST_TILE + row * 128 + d4;
        u32x2 Lv[16];
#pragma unroll
        for (int c = 0; c < 16; ++c) Lv[c] = *(const u32x2*)(base + (size_t)c * LST_TILE);
        float G0 = 0.f, G1 = 0.f, G2 = 0.f, G3 = 0.f, m = -1e30f;
        const float lg2g = log2f(1.0f - exp2f(-5.0f - (float)h)); const float rdec = exp2f(128.0f * lg2g);
#pragma unroll
        for (int c = 0; c < 16; ++c) {
            u32x2 o; o[0] = pk2(G0, G1); o[1] = pk2(G2, G3); *(u32x2*)(base + (size_t)c * LST_TILE) = o;
            float dec = rdec, fac = 1.0f;
            if (grp) { const float Bt = CHK[(bh * 16 + c) * 2], Am = CHK[(bh * 16 + c) * 2 + 1]; const float Ml = fmaxf(m, Am); dec = __expf(m - Ml); fac = __expf(Am - Ml); m = Bt + Ml; }
            const float l0 = __uint_as_float(Lv[c][0] << 16), l1 = __uint_as_float(Lv[c][0] & 0xffff0000u), l2 = __uint_as_float(Lv[c][1] << 16), l3 = __uint_as_float(Lv[c][1] & 0xffff0000u);
            G0 = dec * G0 + fac * l0; G1 = dec * G1 + fac * l1; G2 = dec * G2 + fac * l2; G3 = dec * G3 + fac * l3;
        }
        if (grp == 0) { float* So = A.out + O_SP + (size_t)bh * 16384; So[(d4 + 0) * 128 + row] = G0; So[(d4 + 1) * 128 + row] = G1; So[(d4 + 2) * 128 + row] = G2; So[(d4 + 3) * 128 + row] = G3; }
        else if (row < 128) *(f32x4*)(A.out + O_CP + (size_t)bh * 16384 + row * 128 + d4) = (f32x4){G0, G1, G2, G3};
        else { *(f32x4*)(A.out + O_NP + bh * 128 + d4) = (f32x4){G0, G1, G2, G3}; if (d4 == 0) A.out[O_MP + bh] = m; }
    }
}

__device__ void out_unit(const Args& A, LAS unsigned char* lds, int seq, int c) {
    const int tid = threadIdx.x, lane = tid & 63, w = __builtin_amdgcn_readfirstlane(tid >> 6);
    const int grp = seq >> 5, b = (seq >> 2) & 7, h = seq & 3, t0 = b * 2048 + c * 128, bh = b * 4 + h;
    LAS float* misc = (LAS float*)(lds + MISC_OFF);
    const float lg2g = log2f(1.0f - exp2f(-5.0f - (float)h));
    const float* GA = (const float*)(A.ws + WS_GA); const float* GCM = (const float*)(A.ws + WS_GCM); const float* GB = (const float*)(A.ws + WS_GB); const float* CHK = (const float*)(A.ws + WS_CHK);
    const bf16_t* L = (const bf16_t*)(A.ws + WS_LST) + (size_t)(seq * 16 + c) * LST_TILE;
    float m_prev = -1e30f;
    if (grp) for (int cc = 0; cc < c; ++cc) m_prev = CHK[(bh * 16 + cc) * 2] + fmaxf(m_prev, CHK[(bh * 16 + cc) * 2 + 1]);
    if (tid < 128) {
        float av = 0.f, cv = 0.f, bv = 0.f;
        if (grp) { const size_t o = (size_t)(t0 + tid) * 4 + h; av = GA[o]; cv = GCM[o]; bv = GB[o]; }
        misc[128 + tid] = av; misc[256 + tid] = cv; misc[384 + tid] = bv;
        if (tid < 64) ((LAS unsigned*)(misc + 512))[tid] = grp ? ((const unsigned*)(L + 128 * 128))[tid] : 0u;
    }
    const bf16_t* PROJ = (const bf16_t*)(A.ws + WS_PROJ) + (size_t)t0 * NPROJ;
    const float* RC = (const float*)(A.ws + WS_RC); const float* RS = (const float*)(A.ws + WS_RS);
    LAS unsigned char* TQ = lds; LAS unsigned char* TK = lds + 32768; LAS unsigned char* TV = lds + 65536; LAS unsigned char* TG = lds + 98304;
    const float kscale = 0.08838834764831845f;
    const int qc = (grp ? 2048 : 0) + h * 128, kc = (grp ? 2560 : 512) + h * 128, vc = (grp ? 3072 : 1024) + h * 128;
    if (grp == 0) { fill_bf16<true>(TQ, PROJ + qc, NPROJ, 128, 128, c * 128, RC, RS, 1.0f, nullptr); fill_bf16<true>(TK, PROJ + kc, NPROJ, 128, 128, c * 128, RC, RS, kscale, nullptr); }
    else { fill_bf16<false>(TQ, PROJ + qc, NPROJ, 128, 128, 0, RC, RS, 1.0f, nullptr); fill_bf16<false>(TK, PROJ + kc, NPROJ, 128, 128, 0, RC, RS, kscale, nullptr); }
    fill_bf16<false>(TV, PROJ + vc, NPROJ, 128, 128, 0, RC, RS, 1.0f, nullptr);
    fill_copy(TG, L);
    __syncthreads();
    if (grp) out_wave<1, false>(A, TQ, TK, TV, TG, misc, m_prev, lg2g, w, lane, t0, 128, h); else out_wave<0, false>(A, TQ, TK, TV, TG, misc, 0.f, lg2g, w, lane, t0, 128, h);
    __syncthreads();
}
__device__ void phase_out_units(const Args& A, LAS unsigned char* lds) { for (int u = blockIdx.x; u < 1024; u += gridDim.x) out_unit(A, lds, u >> 4, u & 15); }

__device__ void phase_norm(const Args& A) {
    const int lane = threadIdx.x & 63, wid = threadIdx.x >> 6;
    const float* MIXO = (const float*)(A.ws + WS_MIXO); float* X1 = (float*)(A.ws + WS_X1); bf16_t* H2 = (bf16_t*)(A.ws + WS_H2);
    for (int r = blockIdx.x * 8 + wid; r < T_ALL; r += gridDim.x * 8) {
        const float* x = xrow(A, r); const float* mo = MIXO + (size_t)r * DM; f32x4 v[4]; float ss = 0.f;
#pragma unroll
        for (int q = 0; q < 4; ++q) { v[q] = *(const f32x4*)(mo + q * 256 + lane * 4); ss += v[q][0] * v[q][0] + v[q][1] * v[q][1] + v[q][2] * v[q][2] + v[q][3] * v[q][3]; }
        ss = wave_sum(ss); const float rstd = rsqrtf(ss * (1.0f / 1024.0f) + 1e-6f); float s2 = 0.f;
#pragma unroll
        for (int q = 0; q < 4; ++q) { const f32x4 gp = *(const f32x4*)(A.in[13] + q * 256 + lane * 4); const f32x4 xv = *(const f32x4*)(x + q * 256 + lane * 4);
            v[q] = xv + v[q] * rstd * gp; *(f32x4*)(X1 + (size_t)r * DM + q * 256 + lane * 4) = v[q]; s2 += v[q][0] * v[q][0] + v[q][1] * v[q][1] + v[q][2] * v[q][2] + v[q][3] * v[q][3]; }
        s2 = wave_sum(s2); const float rstd2 = rsqrtf(s2 * (1.0f / 1024.0f) + 1e-6f);
#pragma unroll
        for (int q = 0; q < 4; ++q) { const f32x4 gp = *(const f32x4*)(A.in[14] + q * 256 + lane * 4); const f32x4 hh = v[q] * rstd2 * gp;
            u32x2 w; w[0] = pk2(hh[0], hh[1]); w[1] = pk2(hh[2], hh[3]); *(u32x2*)(H2 + (size_t)r * DM + q * 256 + lane * 4) = w; }
    }
}

__device__ __forceinline__ float gelu_tanh(float x) { const float y = x + 0.044715f * x * x * x; return x * __builtin_amdgcn_rcpf(1.0f + __builtin_amdgcn_exp2f(-2.302208198f * y)); }
__device__ __forceinline__ float dpp_ror1(float v) { return __int_as_float(__builtin_amdgcn_update_dpp(0, __float_as_int(v), 0x121, 0xf, 0xf, false)); }
__device__ __forceinline__ float dpp_ror2(float v) { return __int_as_float(__builtin_amdgcn_update_dpp(0, __float_as_int(v), 0x122, 0xf, 0xf, false)); }

struct EpiConv {
    static constexpr bool PERM = false, AFTER_DRAIN = false;
    bf16_t* act; float* edge; float* head; const float* cw; const float* cb; const float* cache; float* convs;
    __device__ __forceinline__ void operator()(const f32x4 (&acc)[2][2][4][2], const pg8::Unit& u, int wr, int wc, int fr, int fq) const {
        const bool sample = u.pm >= 64;
#pragma unroll
        for (int n = 0; n < 2; ++n) {
            const int j0 = 128 * u.pn + 32 * wc + 16 * n + 4 * fq;
            const f32x4 w0g = *(const f32x4*)(cw + j0), w1g = *(const f32x4*)(cw + NUP + j0), w2g = *(const f32x4*)(cw + 2 * NUP + j0), bg = *(const f32x4*)(cb + j0);
            const f32x4 w0v = *(const f32x4*)(cw + DFF + j0), w1v = *(const f32x4*)(cw + NUP + DFF + j0), w2v = *(const f32x4*)(cw + 2 * NUP + DFF + j0), bv = *(const f32x4*)(cb + DFF + j0);
#pragma unroll
            for (int ai = 0; ai < 2; ++ai)
#pragma unroll
                for (int m = 0; m < 4; ++m) {
                    const int r = u.pm * 256 + ai * 128 + wr * 64 + m * 16 + fr;
                    const f32x4 cg_ = acc[ai][0][m][n], cv_ = acc[ai][1][m][n];
                    f32x4 p1g, p2g, p1v, p2v; bool writeact = true;
                    if (!sample) {
                        f32x4 x1g = cg_, x2g = cg_, x1v = cv_, x2v = cv_;
                        if (m > 0) { const f32x4 pg_ = acc[ai][0][m > 0 ? m - 1 : 0][n], pv_ = acc[ai][1][m > 0 ? m - 1 : 0][n];
                            if (fr == 15) { x1g = pg_; x1v = pv_; } if (fr >= 14) { x2g = pg_; x2v = pv_; } }
#pragma unroll
                        for (int e = 0; e < 4; ++e) { p1g[e] = dpp_ror1(x1g[e]); p2g[e] = dpp_ror2(x2g[e]); p1v[e] = dpp_ror1(x1v[e]); p2v[e] = dpp_ror2(x2v[e]); }
                        const int G64 = r >> 6;
                        if (m == 0 && fr < 2) { writeact = false; float* hp = head + ((size_t)G64 * 2 + fr) * NUP + j0; *(f32x4*)hp = cg_; *(f32x4*)(hp + DFF) = cv_; }
                        if (m == 3 && fr >= 14) { float* ep = edge + ((size_t)G64 * 2 + (fr - 14)) * NUP + j0; *(f32x4*)ep = cg_; *(f32x4*)(ep + DFF) = cv_; }
                    } else {
#pragma unroll
                        for (int e = 0; e < 4; ++e) { p1g[e] = dpp_ror1(cg_[e]); p2g[e] = dpp_ror2(cg_[e]); p1v[e] = dpp_ror1(cv_[e]); p2v[e] = dpp_ror2(cv_[e]); }
                        const int sq = fr & 7, bb = (r - T_P) >> 3;
                        if (sq < 2) { const float* c0 = cache + (size_t)bb * 2 * NUP + j0; const f32x4 k0g = *(const f32x4*)c0, k0v = *(const f32x4*)(c0 + DFF), k1g = *(const f32x4*)(c0 + NUP), k1v = *(const f32x4*)(c0 + NUP + DFF);
                            if (sq == 0) { p2g = k0g; p2v = k0v; p1g = k1g; p1v = k1v; } else { p2g = k1g; p2v = k1v; } }
                        if (sq >= 6) { float* op = convs + ((size_t)bb * 2 + (sq - 6)) * NUP + j0; *(f32x4*)op = cg_; *(f32x4*)(op + DFF) = cv_; }
                    }
                    if (writeact) {
                        const f32x4 yg = w0g * p2g + w1g * p1g + w2g * cg_ + bg, yv = w0v * p2v + w1v * p1v + w2v * cv_ + bv;
                        u32x2 o; o[0] = pk2(gelu_tanh(yg[0]) * yv[0], gelu_tanh(yg[1]) * yv[1]); o[1] = pk2(gelu_tanh(yg[2]) * yv[2], gelu_tanh(yg[3]) * yv[3]);
                        *(u32x2*)(act + (size_t)r * DFF + j0) = o;
                    }
                }
        }
    }
};

__device__ void phase_conv_fixup(const Args& A) {
    const float* edge = (const float*)(A.ws + WS_EDGE); const float* head = (const float*)(A.ws + WS_HEAD); bf16_t* act = (bf16_t*)(A.ws + WS_ACT);
    const float* cw = A.in[16]; const float* cb = A.in[17];
    for (int idx = blockIdx.x * 512 + threadIdx.x; idx < 256 * 2 * 704; idx += gridDim.x * 512) {
        const int j0 = (idx % 704) * 4, rho = (idx / 704) & 1, G = idx / 1408;
        const float* hp = head + ((size_t)G * 2 + rho) * NUP + j0; const f32x4 cg_ = *(const f32x4*)hp, cv_ = *(const f32x4*)(hp + DFF);
        f32x4 p1g = {0.f, 0.f, 0.f, 0.f}, p2g = p1g, p1v = p1g, p2v = p1g;
        if ((G & 31) != 0) {
            const float* e0 = edge + ((size_t)(G - 1) * 2) * NUP + j0; const float* e1 = e0 + NUP;
            if (rho == 0) { p2g = *(const f32x4*)e0; p2v = *(const f32x4*)(e0 + DFF); p1g = *(const f32x4*)e1; p1v = *(const f32x4*)(e1 + DFF); }
            else { p2g = *(const f32x4*)e1; p2v = *(const f32x4*)(e1 + DFF); }
        }
        if (rho == 1) { const float* h0 = head + ((size_t)G * 2) * NUP + j0; p1g = *(const f32x4*)h0; p1v = *(const f32x4*)(h0 + DFF); }
        const f32x4 w0g = *(const f32x4*)(cw + j0), w1g = *(const f32x4*)(cw + NUP + j0), w2g = *(const f32x4*)(cw + 2 * NUP + j0), bg = *(const f32x4*)(cb + j0);
        const f32x4 w0v = *(const f32x4*)(cw + DFF + j0), w1v = *(const f32x4*)(cw + NUP + DFF + j0), w2v = *(const f32x4*)(cw + 2 * NUP + DFF + j0), bv = *(const f32x4*)(cb + DFF + j0);
        const f32x4 yg = w0g * p2g + w1g * p1g + w2g * cg_ + bg, yv = w0v * p2v + w1v * p1v + w2v * cv_ + bv;
        u32x2 o; o[0] = pk2(gelu_tanh(yg[0]) * yv[0], gelu_tanh(yg[1]) * yv[1]); o[1] = pk2(gelu_tanh(yg[2]) * yv[2], gelu_tanh(yg[3]) * yv[3]);
        *(u32x2*)(act + (size_t)(G * 64 + rho) * DFF + j0) = o;
    }
    for (int idx = blockIdx.x * 512 + threadIdx.x; idx < 8 * 2 * 1408; idx += gridDim.x * 512) {
        const int c4 = (idx % 1408) * 4, rho = (idx / 1408) & 1, b = idx / 2816;
        *(f32x4*)(A.out + O_BP + ((size_t)b * 2 + rho) * NUP + c4) = *(const f32x4*)(edge + ((size_t)(b * 32 + 31) * 2 + rho) * NUP + c4);
    }
}

__device__ void phase_final(const Args& A) {
    const int lane = threadIdx.x & 63, wid = threadIdx.x >> 6;
    const float* X1 = (const float*)(A.ws + WS_X1);
    for (int r = blockIdx.x * 8 + wid; r < T_ALL; r += gridDim.x * 8) {
        float* y = A.out + (size_t)r * DM; f32x4 v[4]; float ss = 0.f;
#pragma unroll
        for (int q = 0; q < 4; ++q) { v[q] = *(const f32x4*)(y + q * 256 + lane * 4); ss += v[q][0] * v[q][0] + v[q][1] * v[q][1] + v[q][2] * v[q][2] + v[q][3] * v[q][3]; }
        ss = wave_sum(ss); const float rstd = rsqrtf(ss * (1.0f / 1024.0f) + 1e-6f);
#pragma unroll
        for (int q = 0; q < 4; ++q) { const f32x4 gp = *(const f32x4*)(A.in[19] + q * 256 + lane * 4); const f32x4 xv = *(const f32x4*)(X1 + (size_t)r * DM + q * 256 + lane * 4);
            *(f32x4*)(y + q * 256 + lane * 4) = xv + v[q] * rstd * gp; }
    }
}

template <class Epi>
__device__ __forceinline__ void run_gemm(LAS unsigned char* lds, const bf16_t* Am, const bf16_t* Bt, int N, int K, const Epi& E) {
    pg8::Gemm g; g.A = Am; g.Bt = Bt; g.M = T_ALL; g.N = N; g.K = K;
    pg8::StaticOrder S; S.init(T_ALL, N, (int)gridDim.x, (int)blockIdx.x);
    pg8::gemm_phase<Epi, pg8::StaticOrder, false>(lds, g, S, E, nullptr);
    __syncthreads();
}

#ifndef PH_LO
#define PH_LO 0
#define PH_HI 99
#endif
#ifndef PHMASK
#define PHMASK 4095
#endif
__global__ void __launch_bounds__(512) fwd_kernel(Args A) {
    extern __shared__ __attribute__((aligned(16))) unsigned char shm[];
    LAS unsigned char* lds = (LAS unsigned char*)shm;
    cg::grid_group grid = cg::this_grid();
    if (PHMASK & 1) { phase_convert_weights(A, lds); phase_prep_rows(A); phase_rope_table(A); }
    grid.sync();
    if (PHMASK & 2) phase_gate_scan(A);
    if (PHMASK & 4) { pg8::EpiBf16<0> E; E.O = (bf16_t*)(A.ws + WS_PROJ); E.ldc = NPROJ; E.bias = nullptr; E.split_cols = 0; E.split_stride = 0;
      run_gemm(lds, (const bf16_t*)(A.ws + WS_H), (const bf16_t*)(A.ws + WS_WIN), NPROJ, 1024, E); }
    grid.sync();
    if (PHMASK & 8) phase_local_and_sample(A, lds);
    grid.sync();
    if (PHMASK & 16) phase_scan(A);
    grid.sync();
    if (PHMASK & 32) phase_out_units(A, lds);
    grid.sync();
    if (PHMASK & 64) { pg8::EpiF32 E; E.C = (float*)(A.ws + WS_MIXO); E.ldc = DM; E.bias = nullptr; run_gemm(lds, (const bf16_t*)(A.ws + WS_MIXIN), (const bf16_t*)(A.ws + WS_WOUT), 1024, 1024, E); }
    grid.sync();
    if (PHMASK & 128) phase_norm(A);
    grid.sync();
    if (PHMASK & 256) { EpiConv E; E.act = (bf16_t*)(A.ws + WS_ACT); E.edge = (float*)(A.ws + WS_EDGE); E.head = (float*)(A.ws + WS_HEAD); E.cw = A.in[16]; E.cb = A.in[17]; E.cache = A.in[6]; E.convs = A.out + O_BS;
      run_gemm(lds, (const bf16_t*)(A.ws + WS_H2), (const bf16_t*)(A.ws + WS_WUP), NUP, 1024, E); }
    grid.sync();
    if (PHMASK & 512) phase_conv_fixup(A);
    grid.sync();
    if (PHMASK & 1024) { pg8::EpiF32 E; E.C = A.out + O_Y; E.ldc = DM; E.bias = nullptr; run_gemm(lds, (const bf16_t*)(A.ws + WS_ACT), (const bf16_t*)(A.ws + WS_WDOWN), 1024, DFF, E); }
    grid.sync();
    if (PHMASK & 2048) phase_final(A);
}

extern "C" void kernel_launch(void* const* d_in, const int* in_sizes, int n_in, void* d_out, int out_size, void* d_ws, size_t ws_size, hipStream_t stream) {
    static int grid = 0;
    if (grid == 0) {
        int dev = 0, cus = 0, per_cu = 0;
        hipGetDevice(&dev); hipDeviceGetAttribute(&cus, hipDeviceAttributeMultiprocessorCount, dev);
        hipFuncSetAttribute((const void*)fwd_kernel, hipFuncAttributeMaxDynamicSharedMemorySize, LDS_BYTES);
        hipOccupancyMaxActiveBlocksPerMultiprocessor(&per_cu, (const void*)fwd_kernel, 512, LDS_BYTES);
        if (per_cu < 1) per_cu = 1;
        if (per_cu > 1) per_cu = 1;
        grid = cus * per_cu; (void)hipGetLastError();
        if (ws_size < 256 * MiB) fprintf(stderr, "kernel_launch: workspace too small (%zu)\n", ws_size);
    }
    Args a{};
    for (int i = 0; i < 20; ++i) a.in[i] = (const float*)d_in[i];
    a.out = (float*)d_out; a.ws = (unsigned char*)d_ws;
    void* args[] = {&a};
    hipError_t e = hipLaunchCooperativeKernel((const void*)fwd_kernel, dim3(grid), dim3(512), args, LDS_BYTES, stream);
    if (e != hipSuccess) fprintf(stderr, "cooperative launch failed: %s (grid %d)\n", hipGetErrorString(e), grid);
}
```

```cpp
#define DUPMASK 0
#define EXTRA_SYNCS 0
#include <hip/hip_runtime.h>
#include <hip/hip_cooperative_groups.h>
#include <cstdio>
namespace cg = cooperative_groups;
namespace pg8 {
#define PG8_LAS __attribute__((address_space(3)))
typedef unsigned short bf16_t;
typedef short bf16x8 __attribute__((ext_vector_type(8)));
typedef float f32x4 __attribute__((ext_vector_type(4)));
typedef unsigned u32x4 __attribute__((ext_vector_type(4)));
constexpr int BM = 256, BK = 64, HALF = 128, HTB = HALF * BK * 2  , STAGE_BYTES = 8 * HTB, NXCD = 8, WGM = 8;

__host__ __device__ __forceinline__ int lds_byte(int r, int c) { const int st = (r >> 4) * 2 + (c >> 5), rr = r & 15, cc = c & 31, ob = rr * 64 + cc * 2; return st * 1024 + (ob ^ (((ob >> 9) & 1) << 5)); }
__host__ __device__ __forceinline__ void stage_rc(int b, int& R, int& C) { const int st = b / 1024, sb = b % 1024, swz = sb ^ (((sb >> 9) & 1) << 5); R = (st >> 1) * 16 + swz / 64; C = (st & 1) * 32 + (swz % 64) / 2; }
__host__ __device__ __forceinline__ int perm32(int rho) { const int n = rho >> 4, i = rho & 15; return 8 * (i >> 2) + 4 * n + (i & 3); }

struct Unit { int pm, pn; };
struct Gemm { const bf16_t* A; const bf16_t* Bt; int M, N, K; };

struct StaticOrder {
    int nM, nN, nwg, G, c;
    __host__ __device__ void init(int M, int N, int G_, int c_) { nM = M / BM; nN = N / BM; nwg = nM * nN; G = G_; c = c_; }
    __host__ __device__ bool next(int i, Unit& u) const {
        const long L = (long)i * G + c; if (L >= nwg) return false;
        int wgid = (int)L; { const int q = nwg / NXCD, r = nwg % NXCD, xcd = wgid % NXCD, off = wgid / NXCD; wgid = (xcd < r ? xcd * (q + 1) : r * (q + 1) + (xcd - r) * q) + off; }
        const int nig = WGM * nN, gid = wgid / nig, fm = gid * WGM, gsz = (nM - fm) < WGM ? (nM - fm) : WGM;
        u.pm = fm + ((wgid % nig) % gsz); u.pn = (wgid % nig) / gsz; return true;
    }
    __device__ __forceinline__ void a_ready(const Unit&) const {}
    __device__ __forceinline__ void done(const Unit&) const {}
};
struct CountedOrder : StaticOrder {
    const unsigned* ready; unsigned need; unsigned* tmo;
    __device__ __forceinline__ void a_ready(const Unit& u) const {
        if (threadIdx.x < 64) {
            const unsigned long long t0 = __builtin_amdgcn_s_memrealtime(); unsigned polls = 0;
            while ((unsigned)__builtin_amdgcn_readfirstlane(__hip_atomic_load(ready + 64 * u.pm, __ATOMIC_RELAXED, __HIP_MEMORY_SCOPE_AGENT)) < need) {
                if ((++polls & 255u) == 0u && __builtin_amdgcn_readfirstlane(__hip_atomic_load(tmo, __ATOMIC_RELAXED, __HIP_MEMORY_SCOPE_AGENT)) != 0u) break;
                if (__builtin_amdgcn_s_memrealtime() - t0 > 2000000ull) {
                    if (threadIdx.x == 0) { unsigned expect = 0u; __hip_atomic_compare_exchange_strong(tmo + 1, &expect, 0x600u | (unsigned)(u.pm & 0xff), __ATOMIC_RELAXED, __ATOMIC_RELAXED, __HIP_MEMORY_SCOPE_AGENT); __hip_atomic_store(tmo, 1u, __ATOMIC_RELAXED, __HIP_MEMORY_SCOPE_AGENT); }
                    break; }
                __builtin_amdgcn_s_sleep(2); }
            __builtin_amdgcn_fence(__ATOMIC_ACQUIRE, "agent");
            asm volatile("s_waitcnt vmcnt(0)" ::: "memory");
        }
#if !defined(BROKEN_HOOK_NO_BARRIER)
        asm volatile("" ::: "memory"); __builtin_amdgcn_s_barrier(); asm volatile("" ::: "memory");
#endif
    }
};

__device__ __forceinline__ unsigned cvt_pk_bf16(float lo, float hi) { unsigned r; asm volatile("v_cvt_pk_bf16_f32 %0, %1, %2" : "=v"(r) : "v"(lo), "v"(hi)); return r; }
typedef float f32x2 __attribute__((ext_vector_type(2)));
__device__ __forceinline__ f32x2 gelu_pk(f32x2 v) {
    const f32x2 av = __builtin_elementwise_abs(v), d = av * 0.2316418882f + 1.0f;
    f32x2 t; t.x = __builtin_amdgcn_rcpf(d.x); t.y = __builtin_amdgcn_rcpf(d.y);
    f32x2 q = t * 0.5307027145f + (-0.7265760135f); q = q * t + 0.7107068705f; q = q * t + (-0.142248368f); q = q * t + 0.127414796f; q = q * t;
    const f32x2 s = (v * v) * (-0.72134752044f);
    f32x2 e; e.x = __builtin_amdgcn_exp2f(s.x); e.y = __builtin_amdgcn_exp2f(s.y);
    const f32x2 m = v * (q * e), r = v - m;
    f32x2 o; o.x = v.x < 0.f ? m.x : r.x; o.y = v.y < 0.f ? m.y : r.y; return o;
}

struct EpiF32 {
    static constexpr bool PERM = false, AFTER_DRAIN = false;
    float* C; int ldc; const float* bias;
    __device__ __forceinline__ void operator()(const f32x4 (&acc)[2][2][4][2], const Unit& u, int wr, int wc, int fr, int fq) const {
        const int row0 = u.pm * BM + wr * 64 + fr, col0 = u.pn * BM + wc * 32 + 4 * fq;
        f32x4 bv[2][2];
#pragma unroll
        for (int bj = 0; bj < 2; ++bj)
#pragma unroll
            for (int n = 0; n < 2; ++n) bv[bj][n] = bias ? *(const f32x4*)(bias + col0 + bj * HALF + n * 16) : (f32x4){0.f, 0.f, 0.f, 0.f};
#pragma unroll
        for (int ai = 0; ai < 2; ++ai)
#pragma unroll
            for (int m = 0; m < 4; ++m) { float* rowp = C + (size_t)(row0 + ai * HALF + m * 16) * ldc + col0;
#pragma unroll
                for (int bj = 0; bj < 2; ++bj)
#pragma unroll
                    for (int n = 0; n < 2; ++n) *(f32x4*)(rowp + bj * HALF + n * 16) = acc[ai][bj][m][n] + bv[bj][n]; }
    }
};
template <int ACT  > struct EpiBf16 {
    static constexpr bool PERM = true, AFTER_DRAIN = false;
    bf16_t* O; int ldc; const float* bias; int split_cols; size_t split_stride;
    __device__ __forceinline__ void operator()(const f32x4 (&acc)[2][2][4][2], const Unit& u, int wr, int wc, int fr, int fq) const {
        const int row0 = u.pm * BM + wr * 64 + fr; int colt = u.pn * BM; bf16_t* base = O;
        if (split_cols) { const int t = colt / split_cols; base += (size_t)t * split_stride; colt -= t * split_cols; }
        const int col0 = colt + wc * 32 + 8 * fq, bcol0 = u.pn * BM + wc * 32 + 8 * fq;
        f32x4 bv[2][2];
#pragma unroll
        for (int bj = 0; bj < 2; ++bj)
#pragma unroll
            for (int n = 0; n < 2; ++n) bv[bj][n] = bias ? *(const f32x4*)(bias + bcol0 + bj * HALF + 4 * n) : (f32x4){0.f, 0.f, 0.f, 0.f};
#pragma unroll
        for (int ai = 0; ai < 2; ++ai)
#pragma unroll
            for (int m = 0; m < 4; ++m) { bf16_t* rowp = base + (size_t)(row0 + ai * HALF + m * 16) * ldc + col0;
#pragma unroll
                for (int bj = 0; bj < 2; ++bj) { f32x4 v0 = acc[ai][bj][m][0] + bv[bj][0], v1 = acc[ai][bj][m][1] + bv[bj][1];
                    if (ACT == 1) { f32x2 a = gelu_pk((f32x2){v0[0], v0[1]}), b = gelu_pk((f32x2){v0[2], v0[3]}), c = gelu_pk((f32x2){v1[0], v1[1]}), d = gelu_pk((f32x2){v1[2], v1[3]});
                        v0 = (f32x4){a.x, a.y, b.x, b.y}; v1 = (f32x4){c.x, c.y, d.x, d.y}; }
                    if (ACT == 2) {
#pragma unroll
                        for (int j = 0; j < 4; ++j) { v0[j] = 0.5f * v0[j] * (1.0f + erff(v0[j] * 0.70710678f)); v1[j] = 0.5f * v1[j] * (1.0f + erff(v1[j] * 0.70710678f)); } }
                    u32x4 w; w.x = cvt_pk_bf16(v0[0], v0[1]); w.y = cvt_pk_bf16(v0[2], v0[3]); w.z = cvt_pk_bf16(v1[0], v1[1]); w.w = cvt_pk_bf16(v1[2], v1[3]);
                    *(u32x4*)(rowp + bj * HALF) = w; } }
    }
};

struct PanelStats {
    unsigned* xbuf;
    unsigned* cnt;
    unsigned* tmo;
    int ntn; float eps;
    unsigned code;
    __device__ __forceinline__ bool run(const f32x4 (&v)[2][2][4][2], const Unit& u, int wr, int wc, int fr, int fq, PG8_LAS unsigned char* lds, int wid, int lane) const {
        typedef float f32x2v __attribute__((ext_vector_type(2)));
        PG8_LAS f32x2v* P = (PG8_LAS f32x2v*)lds;
        PG8_LAS f32x2v* S = (PG8_LAS f32x2v*)(lds + 8192);
        PG8_LAS unsigned* flag = (PG8_LAS unsigned*)(lds + 8192 + 2048);
#pragma unroll
        for (int ai = 0; ai < 2; ++ai)
#pragma unroll
            for (int m = 0; m < 4; ++m) {
                float s = 0.f;
#pragma unroll
                for (int bj = 0; bj < 2; ++bj)
#pragma unroll
                    for (int n = 0; n < 2; ++n) { const f32x4 x = v[ai][bj][m][n]; s += (x[0] + x[1]) + (x[2] + x[3]); }
                s += __shfl_xor(s, 16); s += __shfl_xor(s, 32);
                const float mw = s * (1.0f / 64.0f); float q = 0.f;
#pragma unroll
                for (int bj = 0; bj < 2; ++bj)
#pragma unroll
                    for (int n = 0; n < 2; ++n) { const f32x4 d = v[ai][bj][m][n] - mw; q += (d[0] * d[0] + d[1] * d[1]) + (d[2] * d[2] + d[3] * d[3]); }
                q += __shfl_xor(q, 16); q += __shfl_xor(q, 32);
                if (fq == 0) P[(ai * HALF + wr * 64 + m * 16 + fr) * 4 + wc] = (f32x2v){mw, q};
            }
        asm volatile("s_waitcnt lgkmcnt(0)" ::: "memory"); __builtin_amdgcn_s_barrier(); asm volatile("" ::: "memory");
#if defined(BROKEN_NO_WAIT)
        if (blockIdx.x >= 64) { const long long t0 = clock64(); while (clock64() - t0 < 60000) __builtin_amdgcn_s_sleep(8); }
#endif
        const int row = wid * 32 + (lane & 31);
        if (lane < 32) {
            const f32x2v a = P[row * 4 + 0], b = P[row * 4 + 1], c = P[row * 4 + 2], d = P[row * 4 + 3];
            const float mt = (a.x + b.x + c.x + d.x) * 0.25f;
            const float da = a.x - mt, db = b.x - mt, dc = c.x - mt, dd = d.x - mt;
            const float m2 = (a.y + b.y) + (c.y + d.y) + 64.0f * ((da * da + db * db) + (dc * dc + dd * dd));
            unsigned long long* slot = (unsigned long long*)xbuf + ((size_t)(u.pm * BM + row) * 4 + u.pn);
            __hip_atomic_store(slot, ((unsigned long long)__float_as_uint(m2) << 32) | __float_as_uint(mt), __ATOMIC_RELAXED, __HIP_MEMORY_SCOPE_AGENT);
        }
        asm volatile("s_waitcnt vmcnt(0)" ::: "memory");
        if (lane == 0) __hip_atomic_fetch_add(cnt + 64 * u.pm, 1u, __ATOMIC_RELAXED, __HIP_MEMORY_SCOPE_AGENT);
        if (wid == 0) {
            bool dead = false; const unsigned long long t0 = __builtin_amdgcn_s_memrealtime(); const unsigned want = 8u * (unsigned)ntn;
            for (;;) {
#if defined(BROKEN_NO_WAIT)
                break;
#endif
                if ((unsigned)__builtin_amdgcn_readfirstlane(__hip_atomic_load(cnt + 64 * u.pm, __ATOMIC_RELAXED, __HIP_MEMORY_SCOPE_AGENT)) >= want) break;
                if (__builtin_amdgcn_s_memrealtime() - t0 > 2000000ull) {
                    if (lane == 0) { unsigned expect = 0u; __hip_atomic_compare_exchange_strong(tmo + 1, &expect, code | (unsigned)(u.pm & 0xff), __ATOMIC_RELAXED, __ATOMIC_RELAXED, __HIP_MEMORY_SCOPE_AGENT);
                                     __hip_atomic_store(tmo, 1u, __ATOMIC_RELAXED, __HIP_MEMORY_SCOPE_AGENT); }
                    dead = true; break; }
                __builtin_amdgcn_s_sleep(2);
            }
            __builtin_amdgcn_fence(__ATOMIC_ACQUIRE, "agent");
            if (lane == 0) flag[0] = dead ? 1u : 0u;
        }
        asm volatile("s_waitcnt vmcnt(0) lgkmcnt(0)" ::: "memory"); __builtin_amdgcn_s_barrier(); asm volatile("" ::: "memory");
        const bool bad = flag[0] != 0u;
        if (lane < 32) {
            const unsigned long long* slot = (const unsigned long long*)xbuf + (size_t)(u.pm * BM + row) * 4; float mt[4], m2[4]; float ms = 0.f;
#pragma unroll
            for (int t = 0; t < 4; ++t) { if (t < ntn) { const unsigned long long w = __hip_atomic_load(slot + t, __ATOMIC_RELAXED, __HIP_MEMORY_SCOPE_AGENT); mt[t] = __uint_as_float((unsigned)w); m2[t] = __uint_as_float((unsigned)(w >> 32)); } else { mt[t] = 0.f; m2[t] = 0.f; } ms += mt[t]; }
            const float mean = ms / (float)ntn; float q = 0.f;
#pragma unroll
            for (int t = 0; t < 4; ++t) if (t < ntn) { const float dm = mt[t] - mean; q += m2[t] + 256.0f * dm * dm; }
            S[row] = (f32x2v){mean, 1.0f / sqrtf(q / (256.0f * (float)ntn) + eps)};
        }
        asm volatile("s_waitcnt lgkmcnt(0)" ::: "memory"); __builtin_amdgcn_s_barrier(); asm volatile("" ::: "memory");
        return bad;
    }
};
struct EpiLnRes {
    static constexpr bool PERM = false, AFTER_DRAIN = true;
    const float* base; float* out; int ldc; const float* bias; PanelStats st; unsigned poison;
    __device__ __forceinline__ void refuse(size_t i0, size_t stride, int M, int N) const { const float q = __builtin_nanf(""); for (size_t i = i0; i < (size_t)M * N; i += stride) out[(i / N) * ldc + i % N] = q;
        if (i0 == 0) { unsigned expect = 0u; __hip_atomic_compare_exchange_strong(st.tmo + 1, &expect, 0x7f0u, __ATOMIC_RELAXED, __ATOMIC_RELAXED, __HIP_MEMORY_SCOPE_AGENT); __hip_atomic_store(st.tmo, 1u, __ATOMIC_RELAXED, __HIP_MEMORY_SCOPE_AGENT); } }
    __device__ __forceinline__ void fused(f32x4 (&acc)[2][2][4][2], const Unit& u, int wr, int wc, int fr, int fq, PG8_LAS unsigned char* lds, int wid, int lane) const {
        typedef float f32x2v __attribute__((ext_vector_type(2)));
        const PG8_LAS f32x2v* S = (const PG8_LAS f32x2v*)(lds + 8192);
        const int col0 = u.pn * BM + wc * 32 + 4 * fq;
#pragma unroll
        for (int bj = 0; bj < 2; ++bj)
#pragma unroll
            for (int n = 0; n < 2; ++n) { const f32x4 bv = bias ? *(const f32x4*)(bias + col0 + bj * HALF + n * 16) : (f32x4){0.f, 0.f, 0.f, 0.f};
#pragma unroll
                for (int ai = 0; ai < 2; ++ai)
#pragma unroll
                    for (int m = 0; m < 4; ++m) acc[ai][bj][m][n] += bv; }
        const bool bad = st.run(acc, u, wr, wc, fr, fq, lds, wid, lane) || poison != 0u;
        const float qnan = __builtin_nanf("");
#pragma unroll
        for (int ai = 0; ai < 2; ++ai)
#pragma unroll
            for (int m = 0; m < 4; ++m) { const int r = ai * HALF + wr * 64 + m * 16 + fr; const f32x2v sr = S[r]; const size_t off = (size_t)(u.pm * BM + r) * ldc + col0;
#pragma unroll
                for (int bj = 0; bj < 2; ++bj)
#pragma unroll
                    for (int n = 0; n < 2; ++n) { const f32x4 bs = *(const f32x4*)(base + off + bj * HALF + n * 16); f32x4 o = bs + (acc[ai][bj][m][n] - sr.x) * sr.y;
                        if (bad) o = (f32x4){qnan, qnan, qnan, qnan}; *(f32x4*)(out + off + bj * HALF + n * 16) = o; }
                asm volatile("" ::: "memory"); }
    }
};
struct EpiLnResLn {
    static constexpr bool PERM = false, AFTER_DRAIN = true;
    const float* base; float* out; bf16_t* xn; int ldc; const float* bias; PanelStats st1, st2; unsigned poison;
    __device__ __forceinline__ void refuse(size_t i0, size_t stride, int M, int N) const { const float q = __builtin_nanf(""); for (size_t i = i0; i < (size_t)M * N; i += stride) { const size_t o = (i / N) * ldc + i % N; out[o] = q; xn[o] = (bf16_t)0x7fc0u; }
        if (i0 == 0) { unsigned expect = 0u; __hip_atomic_compare_exchange_strong(st1.tmo + 1, &expect, 0x7f0u, __ATOMIC_RELAXED, __ATOMIC_RELAXED, __HIP_MEMORY_SCOPE_AGENT); __hip_atomic_store(st1.tmo, 1u, __ATOMIC_RELAXED, __HIP_MEMORY_SCOPE_AGENT); } }
    __device__ __forceinline__ void fused(f32x4 (&acc)[2][2][4][2], const Unit& u, int wr, int wc, int fr, int fq, PG8_LAS unsigned char* lds, int wid, int lane) const {
        typedef float f32x2v __attribute__((ext_vector_type(2))); typedef unsigned u32x2v __attribute__((ext_vector_type(2)));
        const PG8_LAS f32x2v* S = (const PG8_LAS f32x2v*)(lds + 8192);
        const int col0 = u.pn * BM + wc * 32 + 4 * fq;
#pragma unroll
        for (int bj = 0; bj < 2; ++bj)
#pragma unroll
            for (int n = 0; n < 2; ++n) { const f32x4 bv = bias ? *(const f32x4*)(bias + col0 + bj * HALF + n * 16) : (f32x4){0.f, 0.f, 0.f, 0.f};
#pragma unroll
                for (int ai = 0; ai < 2; ++ai)
#pragma unroll
                    for (int m = 0; m < 4; ++m) acc[ai][bj][m][n] += bv; }
        bool bad = st1.run(acc, u, wr, wc, fr, fq, lds, wid, lane) || poison != 0u;
        const float qnan = __builtin_nanf("");
#pragma unroll
        for (int ai = 0; ai < 2; ++ai)
#pragma unroll
            for (int m = 0; m < 4; ++m) { const int r = ai * HALF + wr * 64 + m * 16 + fr; const f32x2v sr = S[r]; const size_t off = (size_t)(u.pm * BM + r) * ldc + col0;
#pragma unroll
                for (int bj = 0; bj < 2; ++bj)
#pragma unroll
                    for (int n = 0; n < 2; ++n) { const f32x4 bs = *(const f32x4*)(base + off + bj * HALF + n * 16); acc[ai][bj][m][n] = bs + (acc[ai][bj][m][n] - sr.x) * sr.y; }
                asm volatile("" : "+v"(acc[ai][0][m][0]), "+v"(acc[ai][0][m][1]), "+v"(acc[ai][1][m][0]), "+v"(acc[ai][1][m][1]));
                if (m & 1) asm volatile("" ::: "memory"); }
        const bool bad1 = bad;
        bad = st2.run(acc, u, wr, wc, fr, fq, lds, wid, lane) || bad;
#pragma unroll
        for (int ai = 0; ai < 2; ++ai)
#pragma unroll
            for (int m = 0; m < 4; ++m) { const int r = ai * HALF + wr * 64 + m * 16 + fr; const f32x2v sr = S[r]; const size_t off = (size_t)(u.pm * BM + r) * ldc + col0;
#pragma unroll
                for (int bj = 0; bj < 2; ++bj)
#pragma unroll
                    for (int n = 0; n < 2; ++n) { const f32x4 x1 = acc[ai][bj][m][n]; *(f32x4*)(out + off + bj * HALF + n * 16) = bad1 ? (f32x4){qnan, qnan, qnan, qnan} : x1;
                        const f32x4 o = (x1 - sr.x) * sr.y; u32x2v w; w.x = cvt_pk_bf16(o[0], o[1]); w.y = cvt_pk_bf16(o[2], o[3]);
                        if (bad) { w.x = 0x7fc07fc0u; w.y = 0x7fc07fc0u; } *(u32x2v*)(xn + off + bj * HALF + n * 16) = w; }
                asm volatile("" ::: "memory"); }
    }
};

template <class Epi, class Sched, bool STAMP = false>
__device__ __forceinline__ void gemm_phase(PG8_LAS unsigned char* lds, const Gemm g, const Sched& S, const Epi& E, unsigned long long* stamps) {
    const int tid = threadIdx.x, wid = __builtin_amdgcn_readfirstlane(tid >> 6), lane = tid & 63, wr = wid >> 2, wc = wid & 3, fr = lane & 15, fq = lane >> 4;
    const int K = g.K, nt = K / BK;
    int ts_lo = 0, ts_hi = 0, nts = 0; const unsigned long long rt_entry = STAMP ? (unsigned long long)wall_clock64() : 0ull;
#define PG8_STAMP() do { if (STAMP && wid == 0 && nts < 64) { const unsigned long long _c = (unsigned long long)clock64(); \
        ts_lo = (lane == nts) ? (int)(unsigned)_c : ts_lo; ts_hi = (lane == nts) ? (int)(unsigned)(_c >> 32) : ts_hi; ++nts; } } while (0)
    PG8_STAMP();
    unsigned voffA[2], voffB[2];
#pragma unroll
    for (int i = 0; i < 2; ++i) { int R, C; stage_rc(tid * 16 + i * 8192, R, C); const int Rb = Epi::PERM ? ((R & ~31) + perm32(R & 31)) : R;
        voffA[i] = (unsigned)(R * K + C) * 2u; voffB[i] = (unsigned)(Rb * K + C) * 2u; }
    const size_t kstep = (size_t)(BK * 2);
    const size_t hstep = (size_t)HALF * K * 2;
    const size_t tstep = 2 * hstep;
    const unsigned ldsw = (unsigned)wid * 1024u;
    const int aoff = lds_byte(wr * 64 + fr, fq * 8), boff = lds_byte(wc * 32 + fr, fq * 8);
#define PG8_SA(b, h) (((b) * 2 + (h)) * HTB)
#define PG8_SB(b, h) ((4 + (b) * 2 + (h)) * HTB)
#define PG8_STAGE(bufoff, gbase, voff) do { _Pragma("unroll") for (int _i = 0; _i < 2; ++_i) \
        __builtin_amdgcn_global_load_lds((const unsigned*)((const char*)(gbase) + (voff)[_i]), (PG8_LAS unsigned*)(lds + (bufoff) + ldsw + _i * 8192), 16, 0, 0); } while (0)
#define PG8_LDA(dst, b, h) do { _Pragma("unroll") for (int m = 0; m < 4; ++m) _Pragma("unroll") for (int k = 0; k < 2; ++k) dst[m][k] = *(const PG8_LAS bf16x8*)(lds + PG8_SA(b, h) + aoff + m * 2048 + k * 1024); } while (0)
#define PG8_LDB(dst, b, h) do { _Pragma("unroll") for (int n = 0; n < 2; ++n) _Pragma("unroll") for (int k = 0; k < 2; ++k) dst[n][k] = *(const PG8_LAS bf16x8*)(lds + PG8_SB(b, h) + boff + n * 2048 + k * 1024); } while (0)
#define PG8_MMA(ai, bj, At, Bt) do { __builtin_amdgcn_s_setprio(1); _Pragma("unroll") for (int m = 0; m < 4; ++m) _Pragma("unroll") for (int n = 0; n < 2; ++n) _Pragma("unroll") for (int k = 0; k < 2; ++k) \
        acc[ai][bj][m][n] = __builtin_amdgcn_mfma_f32_16x16x32_bf16(Bt[n][k], At[m][k], acc[ai][bj][m][n], 0, 0, 0); __builtin_amdgcn_s_setprio(0); } while (0)
#define PG8_WAIT_V(n) asm volatile("s_waitcnt vmcnt(" #n ")" ::: "memory")
#define PG8_WAIT_L(n) asm volatile("s_waitcnt lgkmcnt(" #n ")" ::: "memory")
#define PG8_BAR __builtin_amdgcn_s_barrier()
#define PG8_SCHED __builtin_amdgcn_sched_barrier(0)
    Unit cur, nxt; int ui = 0;
    if (!S.next(0, cur)) return;
    f32x4 acc[2][2][4][2];
#pragma unroll
    for (int a = 0; a < 2; ++a)
#pragma unroll
        for (int b = 0; b < 2; ++b)
#pragma unroll
            for (int m = 0; m < 4; ++m)
#pragma unroll
                for (int n = 0; n < 2; ++n) acc[a][b][m][n] = (f32x4){0.f, 0.f, 0.f, 0.f};
    bf16x8 At[4][2], B0[2][2], B1[2][2];
    const char* cA = (const char*)g.A + (size_t)cur.pm * tstep; const char* cB = (const char*)g.Bt + (size_t)cur.pn * tstep;
    S.a_ready(cur);
    PG8_STAGE(PG8_SB(0, 0), cB, voffB); PG8_STAGE(PG8_SA(0, 0), cA, voffA); PG8_STAGE(PG8_SB(0, 1), cB + hstep, voffB); PG8_STAGE(PG8_SA(0, 1), cA + hstep, voffA);
    if (wr == 1) PG8_BAR;
    PG8_WAIT_V(4); PG8_BAR;
    PG8_STAGE(PG8_SB(1, 0), cB + kstep, voffB); PG8_STAGE(PG8_SA(1, 0), cA + kstep, voffA); PG8_STAGE(PG8_SB(1, 1), cB + hstep + kstep, voffB);
    PG8_WAIT_V(6); PG8_BAR;
    PG8_STAMP();
    for (;;) {
        const bool has_next = S.next(ui + 1, nxt);
        const char* nA = has_next ? (const char*)g.A + (size_t)nxt.pm * tstep : cA; const char* nB = has_next ? (const char*)g.Bt + (size_t)nxt.pn * tstep : cB;
        for (int t = 0; t < nt; t += 2) {
            const bool last = (t == nt - 2);
            const char* a1 = cA + (size_t)(t + 1) * kstep;
            const char* a2 = last ? nA : cA + (size_t)(t + 2) * kstep; const char* b2 = last ? nB : cB + (size_t)(t + 2) * kstep;
            const char* a3 = a2 + kstep; const char* b3 = b2 + kstep;
            if (last && has_next) S.a_ready(nxt);
            PG8_LDB(B0, 0, 0); PG8_SCHED; PG8_LDA(At, 0, 0); PG8_STAGE(PG8_SA(1, 1), a1 + hstep, voffA);
            PG8_WAIT_L(8); PG8_BAR; PG8_WAIT_L(0); PG8_MMA(0, 0, At, B0); PG8_BAR; PG8_SCHED;
            PG8_LDB(B1, 0, 1); PG8_STAGE(PG8_SB(0, 0), b2, voffB);
            PG8_BAR; PG8_WAIT_L(0); PG8_MMA(0, 1, At, B1); PG8_BAR;
            PG8_LDA(At, 0, 1); PG8_STAGE(PG8_SA(0, 0), a2, voffA);
            PG8_BAR; PG8_WAIT_L(0); PG8_MMA(1, 0, At, B0); PG8_BAR; PG8_SCHED;
            PG8_STAGE(PG8_SB(0, 1), b2 + hstep, voffB);
            PG8_WAIT_V(6); PG8_BAR; PG8_MMA(1, 1, At, B1); PG8_BAR;
            PG8_LDB(B0, 1, 0); PG8_SCHED; PG8_LDA(At, 1, 0); PG8_STAGE(PG8_SA(0, 1), a2 + hstep, voffA);
            PG8_WAIT_L(8); PG8_BAR; PG8_WAIT_L(0); PG8_MMA(0, 0, At, B0); PG8_BAR; PG8_SCHED;
            PG8_LDB(B1, 1, 1); PG8_STAGE(PG8_SB(1, 0), b3, voffB);
            PG8_BAR; PG8_WAIT_L(0); PG8_MMA(0, 1, At, B1); PG8_BAR;
            PG8_LDA(At, 1, 1); PG8_STAGE(PG8_SA(1, 0), a3, voffA);
            PG8_BAR; PG8_WAIT_L(0); PG8_MMA(1, 0, At, B0); PG8_BAR; PG8_SCHED;
            PG8_STAGE(PG8_SB(1, 1), b3 + hstep, voffB);
            PG8_WAIT_V(6); PG8_BAR; PG8_MMA(1, 1, At, B1); PG8_BAR;
        }
        PG8_STAMP();
        if constexpr (!Epi::AFTER_DRAIN) { E(acc, cur, wr, wc, fr, fq); S.done(cur); }
        PG8_STAMP();
        if (!has_next) break;
#pragma unroll
        for (int a = 0; a < 2; ++a)
#pragma unroll
            for (int b = 0; b < 2; ++b)
#pragma unroll
                for (int m = 0; m < 4; ++m)
#pragma unroll
                    for (int n = 0; n < 2; ++n) acc[a][b][m][n] = (f32x4){0.f, 0.f, 0.f, 0.f};
        cur = nxt; cA = nA; cB = nB; ++ui;
    }
    PG8_WAIT_V(0);
    if (wr == 0) PG8_BAR;
    PG8_BAR;
    if constexpr (Epi::AFTER_DRAIN) { E.fused(acc, cur, wr, wc, fr, fq, lds, wid, lane); S.done(cur); }
    PG8_STAMP();
    if (STAMP && wid == 0) { stamps[lane] = lane < nts ? (((unsigned long long)(unsigned)ts_hi << 32) | (unsigned)ts_lo) : 0ull;
        if (lane == 62) stamps[62] = rt_entry; if (lane == 63) stamps[63] = (unsigned long long)wall_clock64(); }
#undef PG8_STAMP
#undef PG8_SA
#undef PG8_SB
#undef PG8_STAGE
#undef PG8_LDA
#undef PG8_LDB
#undef PG8_MMA
#undef PG8_WAIT_V
#undef PG8_WAIT_L
#undef PG8_BAR
#undef PG8_SCHED
}
}

#define LAS __attribute__((address_space(3)))
using pg8::bf16_t; using pg8::bf16x8; using pg8::f32x4; using pg8::u32x4;
typedef unsigned u32x2 __attribute__((ext_vector_type(2)));
typedef short s16x4 __attribute__((ext_vector_type(4)));

constexpr int T_ALL = 17408, T_P = 16384, DM = 1024, NPROJ = 4096, NIN = 4104, NUP = 5632, DFF = 2816;
constexpr int LDS_BYTES = 131072 + 4096;
constexpr int MISC_OFF = 131072;
constexpr size_t MiB = (size_t)1 << 20;
constexpr size_t al256(size_t x) { return (x + 255) & ~(size_t)255; }
constexpr size_t WS_WIN = 0, WS_WOUT = 8 * MiB, WS_WUP = 10 * MiB, WS_WDOWN = 21 * MiB;
constexpr size_t WS_GATES = 27 * MiB;
constexpr size_t WS_RC = al256(WS_GATES + (size_t)T_ALL * 8 * 4);
constexpr size_t WS_RS = al256(WS_RC + (size_t)2056 * 64 * 4);
constexpr size_t WS_GA = al256(WS_RS + (size_t)2056 * 64 * 4);
constexpr size_t WS_GCM = al256(WS_GA + (size_t)T_ALL * 4 * 4);
constexpr size_t WS_GB = al256(WS_GCM + (size_t)T_ALL * 4 * 4);
constexpr size_t WS_CHK = al256(WS_GB + (size_t)T_ALL * 4 * 4);
constexpr size_t WS_BAR = al256(WS_CHK + 1024 * 2 * 4);
constexpr size_t WS_SMALL_END = al256(WS_BAR + 3456 * 4);
static_assert(WS_SMALL_END <= 30 * MiB, "small region overflow");
constexpr size_t WS_X1 = 30 * MiB;
constexpr size_t WS_H = WS_X1, WS_LST = WS_X1 + 34 * MiB, WS_MIXIN = WS_X1;
constexpr size_t WS_PROJ = 98 * MiB;
constexpr size_t WS_MIXO = 98 * MiB;
constexpr size_t WS_ACT = 98 * MiB;
constexpr size_t WS_EDGE = 192 * MiB, WS_HEAD = 204 * MiB;
constexpr size_t WS_H2 = 222 * MiB;
constexpr int LST_TILE = 136 * 128;
constexpr size_t O_Y = 0, O_SP = 17825792, O_SS = 18350080, O_CP = 26738688, O_CS = 27262976, O_NP = 35651584, O_NS = 35655680, O_MP = 35721216, O_MS = 35721248, O_BP = 35721760, O_BS = 35811872;

struct Args { const float* in[20]; float* out; unsigned char* ws; };

__device__ __forceinline__ float bf2f(unsigned short b) { return __uint_as_float(((unsigned)b) << 16); }
__device__ __forceinline__ unsigned pk2(float lo, float hi) { return pg8::cvt_pk_bf16(lo, hi); }
__device__ __forceinline__ float wave_sum(float v) {
#pragma unroll
    for (int o = 32; o >= 1; o >>= 1) v += __shfl_xor(v, o);
    return v; }
__device__ __forceinline__ const float* xrow(const Args& A, int r) { return r < T_P ? A.in[0] + (size_t)r * DM : A.in[1] + (size_t)(r - T_P) * DM; }
__device__ __forceinline__ float sigmoidf_(float x) { return 1.0f / (1.0f + __expf(-x)); }

__device__ __forceinline__ unsigned off_b(unsigned row, unsigned ch) { return 256u * row + 16u * (ch ^ (((row & 3) << 2) | ((row >> 2) & 3))); }
__device__ __forceinline__ unsigned rr_base(int lane) { return off_b(lane & 15, lane >> 4); }
__device__ __forceinline__ bf16x8 row_read(LAS unsigned char* tile, unsigned rr0, int rb, int s) { return *(const LAS bf16x8*)(tile + ((rr0 ^ (unsigned)(s << 6)) + 4096u * (unsigned)rb)); }
__device__ __forceinline__ unsigned tr_base_std(int lane, int t) { const unsigned g = lane >> 4, q = (lane & 15) >> 2, p = lane & 3; return 256u * (8 * g + 4 * t + q) + 16u * ((p >> 1) ^ ((q << 2) | ((2 * g + t) & 3))) + 8u * (p & 1); }
__device__ __forceinline__ unsigned tr_base_perm(int lane) { const unsigned g = lane >> 4, q = (lane & 15) >> 2, p = lane & 3; return 256u * (4 * g + q) + 16u * ((p >> 1) ^ ((q << 2) | g)) + 8u * (p & 1); }
__device__ __forceinline__ bf16x8 tr_frag(unsigned a0, unsigned a1) {
    s16x4 r0, r1;
    asm volatile("ds_read_b64_tr_b16 %0, %2\n\tds_read_b64_tr_b16 %1, %3\n\ts_waitcnt lgkmcnt(0)" : "=&v"(r0), "=&v"(r1) : "v"(a0), "v"(a1) : "memory");
    return __builtin_shufflevector(r0, r1, 0, 1, 2, 3, 4, 5, 6, 7); }
__device__ __forceinline__ void tr_frag2(unsigned a0, unsigned a1, unsigned a2, unsigned a3, bf16x8& f0, bf16x8& f1) {
    s16x4 r0, r1, r2, r3;
    asm volatile("ds_read_b64_tr_b16 %0, %4\n\tds_read_b64_tr_b16 %1, %5\n\tds_read_b64_tr_b16 %2, %6\n\tds_read_b64_tr_b16 %3, %7\n\ts_waitcnt lgkmcnt(0)"
                 : "=&v"(r0), "=&v"(r1), "=&v"(r2), "=&v"(r3) : "v"(a0), "v"(a1), "v"(a2), "v"(a3) : "memory");
    f0 = __builtin_shufflevector(r0, r1, 0, 1, 2, 3, 4, 5, 6, 7); f1 = __builtin_shufflevector(r2, r3, 0, 1, 2, 3, 4, 5, 6, 7); }
#define OPAQUE(x) asm volatile("" : "+v"(x))
#define MFMA16(a, b, c) __builtin_amdgcn_mfma_f32_16x16x32_bf16((a), (b), (c), 0, 0, 0)

template <bool ROT>
__device__ __forceinline__ void fill_bf16(LAS unsigned char* tile, const bf16_t* src, int ld, int nvalid, int ntotal, int pos0, const float* RC, const float* RS, float scale, const LAS float* wrow) {
    for (int idx = threadIdx.x; idx < ntotal * 8; idx += 512) {
        const int row = idx >> 3, ch = idx & 7;
        u32x4 lo = {0u, 0u, 0u, 0u}, hi = {0u, 0u, 0u, 0u};
        if (row < nvalid) {
            const bf16_t* p = src + (size_t)row * ld + ch * 8; lo = *(const u32x4*)p; hi = *(const u32x4*)(p + 64);
            if (ROT || scale != 1.0f || wrow != nullptr) {
                float a[8], b[8];
#pragma unroll
                for (int j = 0; j < 4; ++j) { a[2 * j] = __uint_as_float(lo[j] << 16); a[2 * j + 1] = __uint_as_float(lo[j] & 0xffff0000u); b[2 * j] = __uint_as_float(hi[j] << 16); b[2 * j + 1] = __uint_as_float(hi[j] & 0xffff0000u); }
                if (ROT) {
                    const float* cp = RC + (size_t)(pos0 + row) * 64 + ch * 8; const float* sp = RS + (size_t)(pos0 + row) * 64 + ch * 8;
                    const f32x4 c0 = *(const f32x4*)cp, c1 = *(const f32x4*)(cp + 4), s0 = *(const f32x4*)sp, s1 = *(const f32x4*)(sp + 4);
#pragma unroll
                    for (int j = 0; j < 8; ++j) { const float cc = j < 4 ? c0[j & 3] : c1[j & 3], ss = j < 4 ? s0[j & 3] : s1[j & 3]; const float x1 = a[j], x2 = b[j]; a[j] = x1 * cc - x2 * ss; b[j] = x1 * ss + x2 * cc; }
                }
                const float m = scale * (wrow != nullptr ? wrow[row] : 1.0f);
#pragma unroll
                for (int j = 0; j < 4; ++j) { lo[j] = pk2(a[2 * j] * m, a[2 * j + 1] * m); hi[j] = pk2(b[2 * j] * m, b[2 * j + 1] * m); }
            }
        }
        *(LAS u32x4*)(tile + off_b(row, ch)) = lo; *(LAS u32x4*)(tile + off_b(row, ch + 8)) = hi;
    }
}
__device__ __forceinline__ void fill_from_f32(LAS unsigned char* tile, const float* src) {
    for (int idx = threadIdx.x; idx < 2048; idx += 512) { const int row = idx >> 4, ch = idx & 15; const float* p = src + row * 128 + ch * 8;
        const f32x4 a = *(const f32x4*)p, b = *(const f32x4*)(p + 4); u32x4 w; w[0] = pk2(a[0], a[1]); w[1] = pk2(a[2], a[3]); w[2] = pk2(b[0], b[1]); w[3] = pk2(b[2], b[3]);
        *(LAS u32x4*)(tile + off_b(row, ch)) = w; }
}
__device__ __forceinline__ void fill_copy(LAS unsigned char* tile, const bf16_t* src) {
    for (int idx = threadIdx.x; idx < 2048; idx += 512) { const int row = idx >> 4, ch = idx & 15; *(LAS u32x4*)(tile + off_b(row, ch)) = *(const u32x4*)(src + row * 128 + ch * 8); }
}

template <int NKS, bool NROW>
__device__ __forceinline__ void local_prod(f32x4 (&acc)[9], unsigned kimg, unsigned vimg, const LAS float* wrow, int w, int lane) {
    const int g = lane >> 4, i = lane & 15;
    const unsigned tb0 = tr_base_std(lane, 0), tb1 = tr_base_std(lane, 1);
#pragma unroll
    for (int ks = 0; ks < NKS; ++ks) {
        unsigned b0_ = tb0, b1_ = tb1; OPAQUE(b0_); OPAQUE(b1_);
        const unsigned ko = kimg + 8192u * ks, vo = vimg + 8192u * ks;
        const bf16x8 a = tr_frag((b0_ ^ ((unsigned)w << 5)) + ko, (b1_ ^ ((unsigned)w << 5)) + ko);
#pragma unroll
        for (int c = 0; c < 8; c += 2) { bf16x8 f0, f1; tr_frag2((b0_ ^ (unsigned)(c << 5)) + vo, (b1_ ^ (unsigned)(c << 5)) + vo, (b0_ ^ (unsigned)((c + 1) << 5)) + vo, (b1_ ^ (unsigned)((c + 1) << 5)) + vo, f0, f1);
            acc[c] = MFMA16(a, f0, acc[c]); acc[c + 1] = MFMA16(a, f1, acc[c + 1]); }
        if (NROW) {
            const int rb0 = 32 * ks + 8 * g;
            const f32x4 w0 = *(const LAS f32x4*)(wrow + rb0), w1 = *(const LAS f32x4*)(wrow + rb0 + 4);
            u32x4 bw; bw[0] = pk2(w0[0], w0[1]); bw[1] = pk2(w0[2], w0[3]); bw[2] = pk2(w1[0], w1[1]); bw[3] = pk2(w1[2], w1[3]);
            if (i != 0) bw = (u32x4){0u, 0u, 0u, 0u};
            acc[8] = MFMA16(a, __builtin_bit_cast(bf16x8, bw), acc[8]);
        }
    }
}

template <int GRP, bool GTR>
__device__ __forceinline__ void out_wave(const Args& A, LAS unsigned char* qimg, LAS unsigned char* kimg, LAS unsigned char* vimg, LAS unsigned char* gimg, const LAS float* misc,
                                         float m_prev, float lg2g, int w, int lane, int t0, int nvalid, int h) {
    const int i = lane & 15, g = lane >> 4;
    const unsigned vbase = (unsigned)(size_t)vimg, gbase = (unsigned)(size_t)gimg;
    const LAS float* a_s = misc + 128; const LAS float* cmx = misc + 256; const LAS float* bbs = misc + 384; const LAS unsigned char* nl = (const LAS unsigned char*)(misc + 512);
    const unsigned rr0 = rr_base(lane);
    bf16x8 qf[4];
#pragma unroll
    for (int kd = 0; kd < 4; ++kd) qf[kd] = row_read(qimg, rr0, w, kd);
    f32x4 pT[8];
#pragma unroll
    for (int c = 0; c < 8; ++c) pT[c] = (f32x4){0.f, 0.f, 0.f, 0.f};
#pragma unroll
    for (int c = 0; c < 8; ++c) if (c <= w) {
#pragma unroll
        for (int kd = 0; kd < 4; ++kd) pT[c] = MFMA16(row_read(kimg, rr0, c, kd), qf[kd], pT[c]);
    }
    const int t = 16 * w + i;
    const float Mt_i = GRP ? fmaxf(m_prev, cmx[t]) : 0.f;
#pragma unroll
    for (int c = 0; c < 8; ++c) if (c <= w) {
        f32x4 av = (f32x4){0.f, 0.f, 0.f, 0.f}; if (GRP) av = *(const LAS f32x4*)(a_s + 16 * c + 4 * g);
#pragma unroll
        for (int r = 0; r < 4; ++r) { const int s = 16 * c + 4 * g + r; float wg;
            if (GRP) wg = __expf(av[r] - Mt_i); else wg = exp2f((float)(t - s) * lg2g);
            pT[c][r] = (s <= t) ? pT[c][r] * wg : 0.f; }
    }
    f32x4 acc[9];
#pragma unroll
    for (int c = 0; c < 9; ++c) acc[c] = (f32x4){0.f, 0.f, 0.f, 0.f};
#pragma unroll
    for (int kd = 0; kd < 4; ++kd) {
#pragma unroll
        for (int cv = 0; cv < 8; cv += 2) {
            bf16x8 b0, b1;
            if (GTR) { unsigned x0 = tr_base_std(lane, 0), x1 = tr_base_std(lane, 1); OPAQUE(x0); OPAQUE(x1); const unsigned go = gbase + 8192u * kd;
                tr_frag2((x0 ^ (unsigned)(cv << 5)) + go, (x1 ^ (unsigned)(cv << 5)) + go, (x0 ^ (unsigned)((cv + 1) << 5)) + go, (x1 ^ (unsigned)((cv + 1) << 5)) + go, b0, b1); }
            else { b0 = row_read(gimg, rr0, cv, kd); b1 = row_read(gimg, rr0, cv + 1, kd); }
            acc[cv] = MFMA16(qf[kd], b0, acc[cv]); acc[cv + 1] = MFMA16(qf[kd], b1, acc[cv + 1]);
        }
        if (GRP) { u32x4 bn = *(const LAS u32x4*)(nl + (32 * kd + 8 * g) * 2); if (i != 0) bn = (u32x4){0u, 0u, 0u, 0u}; acc[8] = MFMA16(qf[kd], __builtin_bit_cast(bf16x8, bn), acc[8]); }
    }
    float Mt_r[4];
#pragma unroll
    for (int r = 0; r < 4; ++r) { const int tl = 16 * w + 4 * g + r; float sc;
        if (GRP) { Mt_r[r] = fmaxf(m_prev, cmx[tl]); sc = __expf(m_prev - Mt_r[r]); } else { Mt_r[r] = 0.f; sc = exp2f((float)(tl + 1) * lg2g); }
#pragma unroll
        for (int c = 0; c < 9; ++c) acc[c][r] *= sc; }
    u32x4 ones = (u32x4){0x3f803f80u, 0x3f803f80u, 0x3f803f80u, 0x3f803f80u}; if (i != 0) ones = (u32x4){0u, 0u, 0u, 0u};
#pragma unroll
    for (int ks = 0; ks < 4; ++ks) if (2 * ks <= w) {
        u32x4 pa; pa[0] = pk2(pT[2 * ks][0], pT[2 * ks][1]); pa[1] = pk2(pT[2 * ks][2], pT[2 * ks][3]); pa[2] = pk2(pT[2 * ks + 1][0], pT[2 * ks + 1][1]); pa[3] = pk2(pT[2 * ks + 1][2], pT[2 * ks + 1][3]);
        const bf16x8 af = __builtin_bit_cast(bf16x8, pa);
        unsigned tp = tr_base_perm(lane); OPAQUE(tp); const unsigned vo = vbase + 8192u * ks;
#pragma unroll
        for (int cv = 0; cv < 8; cv += 2) { bf16x8 b0, b1; const unsigned y0 = (tp ^ (unsigned)(cv << 5)) + vo, y1 = (tp ^ (unsigned)((cv + 1) << 5)) + vo;
            tr_frag2(y0, y0 + 4096u, y1, y1 + 4096u, b0, b1); acc[cv] = MFMA16(af, b0, acc[cv]); acc[cv + 1] = MFMA16(af, b1, acc[cv + 1]); }
        if (GRP) acc[8] = MFMA16(af, __builtin_bit_cast(bf16x8, ones), acc[8]);
    }
    const float* gain = (GRP ? A.in[11] : A.in[10]) + h * 128;
    const bf16_t* PROJ = (const bf16_t*)(A.ws + WS_PROJ); bf16_t* MIXIN = (bf16_t*)(A.ws + WS_MIXIN);
    const int gcol = (GRP ? 3584 : 1536) + h * 128;
    float gn[8];
#pragma unroll
    for (int cv = 0; cv < 8; ++cv) gn[cv] = gain[16 * cv + i];
#pragma unroll
    for (int r = 0; r < 4; ++r) {
        const int tl = 16 * w + 4 * g + r;
        float hv[8];
        float inv = 1.0f;
        if (GRP) { const float dd = __shfl(acc[8][r], lane & 48); const float mt = bbs[tl] + Mt_r[r]; inv = 1.0f / fmaxf(fabsf(dd), __expf(-mt)); }
        float s1 = 0.f;
#pragma unroll
        for (int cv = 0; cv < 8; ++cv) { hv[cv] = acc[cv][r] * inv; s1 += hv[cv]; }
        s1 += __shfl_xor(s1, 1); s1 += __shfl_xor(s1, 2); s1 += __shfl_xor(s1, 4); s1 += __shfl_xor(s1, 8);
        const float mu = s1 * (1.0f / 128.0f); float s2 = 0.f;
#pragma unroll
        for (int cv = 0; cv < 8; ++cv) { const float d = hv[cv] - mu; s2 += d * d; }
        s2 += __shfl_xor(s2, 1); s2 += __shfl_xor(s2, 2); s2 += __shfl_xor(s2, 4); s2 += __shfl_xor(s2, 8);
        const float rstd = rsqrtf(s2 * (1.0f / 128.0f) + 1e-6f);
        if (tl < nvalid) {
            const bf16_t* gp = PROJ + (size_t)(t0 + tl) * NPROJ + gcol + i; bf16_t* op = MIXIN + (size_t)(t0 + tl) * DM + GRP * 512 + h * 128 + i;
#pragma unroll
            for (int cv = 0; cv < 8; ++cv) { const float gv = bf2f(gp[16 * cv]); const float sg = sigmoidf_(gv); const float act = GRP ? sg : gv * sg;
                const float y = (hv[cv] - mu) * rstd * gn[cv] * act; op[16 * cv] = (bf16_t)(pk2(y, y) & 0xffffu); }
        }
    }
}

__device__ void phase_convert_weights(const Args& A, LAS unsigned char* lds) {
    LAS float* tile = (LAS float*)lds;
    const int tid = threadIdx.x;
    constexpr int NT_IN = 64 * 16, NT_OUT = 16 * 16, NT_UP = 88 * 16, NT_DOWN = 16 * 44;
    for (int t = blockIdx.x; t < NT_IN + NT_OUT + NT_UP + NT_DOWN; t += gridDim.x) {
        const float* W; bf16_t* Bt; int K, ld, which, tt = t;
        if (tt < NT_IN) { which = 0; W = A.in[8]; ld = NIN; K = 1024; Bt = (bf16_t*)(A.ws + WS_WIN); }
        else if ((tt -= NT_IN) < NT_OUT) { which = 1; W = A.in[12]; ld = 1024; K = 1024; Bt = (bf16_t*)(A.ws + WS_WOUT); }
        else if ((tt -= NT_OUT) < NT_UP) { which = 2; W = A.in[15]; ld = NUP; K = 1024; Bt = (bf16_t*)(A.ws + WS_WUP); }
        else { tt -= NT_UP; which = 3; W = A.in[18]; ld = 1024; K = 2816; Bt = (bf16_t*)(A.ws + WS_WDOWN); }
        const int ktiles = K / 64, nt = tt / ktiles, kt = tt % ktiles, n0 = nt * 64, k0 = kt * 64;
        int c0 = n0; if (which == 2) { const int pn = n0 >> 8, bj = (n0 >> 7) & 1, ii = n0 & 127; c0 = bj * DFF + 128 * pn + ii; }
        { const int k = tid >> 3, n8 = (tid & 7) * 8; const float* p = W + (size_t)(k0 + k) * ld + c0 + n8;
          const f32x4 a = *(const f32x4*)p, b = *(const f32x4*)(p + 4); LAS float* d = tile + k * 65 + n8;
          d[0] = a[0]; d[1] = a[1]; d[2] = a[2]; d[3] = a[3]; d[4] = b[0]; d[5] = b[1]; d[6] = b[2]; d[7] = b[3]; }
        __syncthreads();
        { const int n = tid >> 3, k8 = (tid & 7) * 8; float v[8];
#pragma unroll
          for (int j = 0; j < 8; ++j) v[j] = tile[(k8 + j) * 65 + n];
          u32x4 w; w[0] = pk2(v[0], v[1]); w[1] = pk2(v[2], v[3]); w[2] = pk2(v[4], v[5]); w[3] = pk2(v[6], v[7]);
          *(u32x4*)(Bt + (size_t)(n0 + n) * K + k0 + k8) = w; }
        __syncthreads();
    }
}

__device__ void phase_prep_rows(const Args& A) {
    const int lane = threadIdx.x & 63, wid = threadIdx.x >> 6;
    bf16_t* H = (bf16_t*)(A.ws + WS_H); float* GATES = (float*)(A.ws + WS_GATES);
    for (int r = blockIdx.x * 8 + wid; r < T_ALL; r += gridDim.x * 8) {
        const float* x = xrow(A, r); f32x4 v[4]; float ss = 0.f;
#pragma unroll
        for (int q = 0; q < 4; ++q) { v[q] = *(const f32x4*)(x + q * 256 + lane * 4); ss += v[q][0] * v[q][0] + v[q][1] * v[q][1] + v[q][2] * v[q][2] + v[q][3] * v[q][3]; }
        ss = wave_sum(ss); const float rstd = rsqrtf(ss * (1.0f / 1024.0f) + 1e-6f);
        float g8[8];
#pragma unroll
        for (int j = 0; j < 8; ++j) g8[j] = 0.f;
#pragma unroll
        for (int q = 0; q < 4; ++q) {
            const f32x4 gn = *(const f32x4*)(A.in[7] + q * 256 + lane * 4); const f32x4 hh = v[q] * rstd * gn;
            u32x2 w; w[0] = pk2(hh[0], hh[1]); w[1] = pk2(hh[2], hh[3]); *(u32x2*)(H + (size_t)r * DM + q * 256 + lane * 4) = w;
#pragma unroll
            for (int e = 0; e < 4; ++e) { const float* wg = A.in[8] + (size_t)(q * 256 + lane * 4 + e) * NIN + 4096; const f32x4 w0 = *(const f32x4*)wg, w1 = *(const f32x4*)(wg + 4);
#pragma unroll
                for (int j = 0; j < 4; ++j) { g8[j] += hh[e] * w0[j]; g8[4 + j] += hh[e] * w1[j]; } }
        }
        float outv = 0.f;
#pragma unroll
        for (int j = 0; j < 8; ++j) { const float s = wave_sum(g8[j]); if (lane == j) outv = s; }
        if (lane < 8) GATES[(size_t)r * 8 + lane] = outv + A.in[9][lane];
    }
}

__device__ void phase_rope_table(const Args& A) {
    float* RC = (float*)(A.ws + WS_RC); float* RS = (float*)(A.ws + WS_RS);
    for (int idx = blockIdx.x * 512 + threadIdx.x; idx < 2056 * 64; idx += gridDim.x * 512) {
        const int p = idx >> 6, i = idx & 63; const double pos = p < 2048 ? (double)p : (double)(16384 + (p - 2048));
        const double freq = exp2(-(double)i * (13.287712379549449 / 64.0)); double rev = pos * freq * 0.15915494309189535; rev -= rint(rev);
        const float fr = (float)rev; RC[idx] = __builtin_amdgcn_cosf(fr); RS[idx] = __builtin_amdgcn_sinf(fr);
    }
}

__device__ __forceinline__ float logsig(float f) { return f > 0.f ? -log1pf(__expf(-f)) : f - log1pf(__expf(f)); }
__device__ void phase_gate_scan(const Args& A) {
    const int lane = threadIdx.x & 63, wid = threadIdx.x >> 6;
    const float* GATES = (const float*)(A.ws + WS_GATES); float* GA = (float*)(A.ws + WS_GA); float* GCM = (float*)(A.ws + WS_GCM); float* GB = (float*)(A.ws + WS_GB); float* CHK = (float*)(A.ws + WS_CHK);
    for (int u = blockIdx.x * 8 + wid; u < 1024; u += gridDim.x * 8) {
        int t0, len, h;
        if (u < 512) { const int b = u >> 6, c = u & 15; h = (u >> 4) & 3; t0 = b * 2048 + c * 128; len = 128; } else { const int v = u - 512, b = v >> 2; h = v & 3; t0 = T_P + b * 8; len = 8; }
        const int s0 = 2 * lane, s1 = s0 + 1; const bool v0 = s0 < len, v1 = s1 < len;
        float i0 = 0.f, i1 = 0.f, l0 = 0.f, l1 = 0.f;
        if (v0) { i0 = GATES[(size_t)(t0 + s0) * 8 + h]; l0 = logsig(GATES[(size_t)(t0 + s0) * 8 + 4 + h]); }
        if (v1) { i1 = GATES[(size_t)(t0 + s1) * 8 + h]; l1 = logsig(GATES[(size_t)(t0 + s1) * 8 + 4 + h]); }
        float x = l0 + l1;
#pragma unroll
        for (int o = 1; o < 64; o <<= 1) { const float y = __shfl_up(x, o); if (lane >= o) x += y; }
        const float ex = x - (l0 + l1), b0 = ex + l0, b1 = b0 + l1;
        const float a0 = v0 ? i0 - b0 : -3e38f, a1 = v1 ? i1 - b1 : -3e38f;
        float mx = fmaxf(a0, a1);
#pragma unroll
        for (int o = 1; o < 64; o <<= 1) { const float y = __shfl_up(mx, o); if (lane >= o) mx = fmaxf(mx, y); }
        float pm = __shfl_up(mx, 1); if (lane == 0) pm = -3e38f;
        const float c0 = fmaxf(pm, a0), c1 = fmaxf(c0, a1);
        if (v0) { const size_t o = (size_t)(t0 + s0) * 4 + h; GB[o] = b0; GA[o] = a0; GCM[o] = c0; }
        if (v1) { const size_t o = (size_t)(t0 + s1) * 4 + h; GB[o] = b1; GA[o] = a1; GCM[o] = c1; }
        const float Btot = __shfl(x, 63), Amax = __shfl(mx, 63);
        if (lane == 0) { CHK[u * 2] = Btot; CHK[u * 2 + 1] = Amax; }
    }
}

__device__ void local_unit(const Args& A, LAS unsigned char* lds, int seq, int c) {
    const int tid = threadIdx.x, lane = tid & 63, w = __builtin_amdgcn_readfirstlane(tid >> 6), g = lane >> 4, i = lane & 15;
    const int grp = seq >> 5, b = (seq >> 2) & 7, h = seq & 3, t0 = b * 2048 + c * 128;
    LAS float* misc = (LAS float*)(lds + MISC_OFF);
    const float lg2g = log2f(1.0f - exp2f(-5.0f - (float)h));
    const float* GA = (const float*)(A.ws + WS_GA); const float* CHK = (const float*)(A.ws + WS_CHK);
    if (tid < 128) { float wv; if (grp == 0) wv = exp2f((float)(127 - tid) * lg2g); else { const float Amax = CHK[((seq & 31) * 16 + c) * 2 + 1]; wv = __expf(GA[(size_t)(t0 + tid) * 4 + h] - Amax); } misc[tid] = wv; }
    __syncthreads();
    const bf16_t* PROJ = (const bf16_t*)(A.ws + WS_PROJ) + (size_t)t0 * NPROJ;
    const float* RC = (const float*)(A.ws + WS_RC); const float* RS = (const float*)(A.ws + WS_RS);
    LAS unsigned char* T0 = lds; LAS unsigned char* T1 = lds + 32768;
    const float kscale = 0.08838834764831845f;
    if (grp == 0) fill_bf16<true>(T0, PROJ + 512 + h * 128, NPROJ, 128, 128, c * 128, RC, RS, kscale, nullptr);
    else fill_bf16<false>(T0, PROJ + 2560 + h * 128, NPROJ, 128, 128, 0, RC, RS, kscale, nullptr);
    fill_bf16<false>(T1, PROJ + (grp ? 3072 : 1024) + h * 128, NPROJ, 128, 128, 0, RC, RS, 1.0f, misc);
    __syncthreads();
    f32x4 acc[9];
#pragma unroll
    for (int q = 0; q < 9; ++q) acc[q] = (f32x4){0.f, 0.f, 0.f, 0.f};
    if (grp) local_prod<4, true>(acc, (unsigned)(size_t)T0, (unsigned)(size_t)T1, misc, w, lane); else local_prod<4, false>(acc, (unsigned)(size_t)T0, (unsigned)(size_t)T1, misc, w, lane);
    bf16_t* L = (bf16_t*)(A.ws + WS_LST) + (size_t)(seq * 16 + c) * LST_TILE;
#pragma unroll
    for (int cc = 0; cc < 8; ++cc) { u32x2 o; o[0] = pk2(acc[cc][0], acc[cc][1]); o[1] = pk2(acc[cc][2], acc[cc][3]); *(u32x2*)(L + (16 * cc + i) * 128 + 16 * w + 4 * g) = o; }
    if (grp && i == 0) { u32x2 o; o[0] = pk2(acc[8][0], acc[8][1]); o[1] = pk2(acc[8][2], acc[8][3]); *(u32x2*)(L + 128 * 128 + 16 * w + 4 * g) = o; }
    __syncthreads();
}

__device__ void sample_unit(const Args& A, LAS unsigned char* lds, int grp, int b, int h) {
    const int tid = threadIdx.x, lane = tid & 63, w = __builtin_amdgcn_readfirstlane(tid >> 6), g = lane >> 4, i = lane & 15;
    const int t0 = T_P + b * 8, bh = b * 4 + h;
    LAS float* misc = (LAS float*)(lds + MISC_OFF);
    const float lg2g = log2f(1.0f - exp2f(-5.0f - (float)h));
    const float* GA = (const float*)(A.ws + WS_GA); const float* GCM = (const float*)(A.ws + WS_GCM); const float* GB = (const float*)(A.ws + WS_GB); const float* CHK = (const float*)(A.ws + WS_CHK);
    float m0 = 0.f, Btot = 0.f, Mlast = 0.f;
    if (grp) { m0 = A.in[5][bh]; Btot = CHK[(512 + bh) * 2]; Mlast = fmaxf(m0, CHK[(512 + bh) * 2 + 1]); }
    if (tid < 128) {
        float wv = 0.f, av = -3e38f, cv = 0.f, bv = 0.f;
        if (tid < 8) { if (grp) { const size_t o = (size_t)(t0 + tid) * 4 + h; av = GA[o]; cv = GCM[o]; bv = GB[o]; wv = __expf(av - Mlast); } else wv = exp2f((float)(7 - tid) * lg2g); }
        misc[tid] = wv; misc[128 + tid] = av; misc[256 + tid] = cv; misc[384 + tid] = bv;
        if (tid < 64) { unsigned nn = 0u; if (grp) nn = pk2(A.in[4][bh * 128 + 2 * tid], A.in[4][bh * 128 + 2 * tid + 1]); ((LAS unsigned*)(misc + 512))[tid] = nn; }
    }
    __syncthreads();
    const bf16_t* PROJ = (const bf16_t*)(A.ws + WS_PROJ) + (size_t)t0 * NPROJ;
    const float* RC = (const float*)(A.ws + WS_RC); const float* RS = (const float*)(A.ws + WS_RS);
    LAS unsigned char* TQ = lds; LAS unsigned char* TK = lds + 8192; LAS unsigned char* TV = lds + 16384; LAS unsigned char* TW = lds + 24576; LAS unsigned char* TG = lds + 32768;
    const float kscale = 0.08838834764831845f;
    const int qc = (grp ? 2048 : 0) + h * 128, kc = (grp ? 2560 : 512) + h * 128, vc = (grp ? 3072 : 1024) + h * 128;
    if (grp == 0) { fill_bf16<true>(TQ, PROJ + qc, NPROJ, 8, 32, 2048, RC, RS, 1.0f, nullptr); fill_bf16<true>(TK, PROJ + kc, NPROJ, 8, 32, 2048, RC, RS, kscale, nullptr); }
    else { fill_bf16<false>(TQ, PROJ + qc, NPROJ, 8, 32, 0, RC, RS, 1.0f, nullptr); fill_bf16<false>(TK, PROJ + kc, NPROJ, 8, 32, 0, RC, RS, kscale, nullptr); }
    fill_bf16<false>(TV, PROJ + vc, NPROJ, 8, 32, 0, RC, RS, 1.0f, nullptr);
    fill_bf16<false>(TW, PROJ + vc, NPROJ, 8, 32, 0, RC, RS, 1.0f, misc);
    const float* S0 = (grp ? A.in[3] : A.in[2]) + (size_t)bh * 16384;
    fill_from_f32(TG, S0);
    __syncthreads();
    if (w == 0) { if (grp) out_wave<1, false>(A, TQ, TK, TV, TG, misc, m0, lg2g, 0, lane, t0, 8, h); else out_wave<0, true>(A, TQ, TK, TV, TG, misc, 0.f, lg2g, 0, lane, t0, 8, h); }
    f32x4 acc[9];
#pragma unroll
    for (int q = 0; q < 9; ++q) acc[q] = (f32x4){0.f, 0.f, 0.f, 0.f};
    if (grp) local_prod<1, true>(acc, (unsigned)(size_t)TK, (unsigned)(size_t)TW, misc, w, lane); else local_prod<1, false>(acc, (unsigned)(size_t)TK, (unsigned)(size_t)TW, misc, w, lane);
    if (grp == 0) {
        const float dec = exp2f(8.0f * lg2g); float* So = A.out + O_SS + (size_t)bh * 16384;
#pragma unroll
        for (int cv = 0; cv < 8; ++cv)
#pragma unroll
            for (int r = 0; r < 4; ++r) { const int idx = (16 * w + 4 * g + r) * 128 + 16 * cv + i; So[idx] = dec * S0[idx] + acc[cv][r]; }
    } else {
        const float dec = __expf(m0 - Mlast); float* Co = A.out + O_CS + (size_t)bh * 16384;
#pragma unroll
        for (int cv = 0; cv < 8; ++cv) { const int idx = (16 * cv + i) * 128 + 16 * w + 4 * g; const f32x4 c0 = *(const f32x4*)(S0 + idx); *(f32x4*)(Co + idx) = c0 * dec + acc[cv]; }
        if (i == 0) { const int d = 16 * w + 4 * g; const f32x4 n0 = *(const f32x4*)(A.in[4] + bh * 128 + d); *(f32x4*)(A.out + O_NS + bh * 128 + d) = n0 * dec + acc[8]; }
        if (tid == 0) A.out[O_MS + bh] = Btot + Mlast;
    }
    __syncthreads();
}

__device__ void phase_local_and_sample(const Args& A, LAS unsigned char* lds) {
    for (int u = blockIdx.x; u < 2048; u += gridDim.x) {
        if (u < 1024) local_unit(A, lds, u >> 4, u & 15);
        else { const int v = u - 1024; sample_unit(A, lds, v >> 9, (v >> 2) & 127, v & 3); }
    }
}

__device__ void phase_scan(const Args& A) {
    bf16_t* LST = (bf16_t*)(A.ws + WS_LST); const float* CHK = (const float*)(A.ws + WS_CHK);
    for (int idx = blockIdx.x * 512 + threadIdx.x; idx < 64 * 4128; idx += gridDim.x * 512) {
        const int seq = idx / 4128, e = idx % 4128, row = e >> 5, d4 = (e & 31) * 4, grp = seq >> 5, b = (seq >> 2) & 7, h = seq & 3, bh = b * 4 + h;
        if (grp == 0 && row == 128) continue;
        bf16_t* base = LST + (size_t)seq * 16 * LST_TILE + row * 128 + d4;
        u32x2 Lv[16];
#pragma unroll
        for (int c = 0; c < 16; ++c) Lv[c] = *(const u32x2*)(base + (size_t)c * LST_TILE);
        float G0 = 0.f, G1 = 0.f, G2 = 0.f, G3 = 0.f, m = -1e30f;
        const float lg2g = log2f(1.0f - exp2f(-5.0f - (float)h)); const float rdec = exp2f(128.0f * lg2g);
#pragma unroll
        for (int c = 0; c < 16; ++c) {
            u32x2 o; o[0] = pk2(G0, G1); o[1] = pk2(G2, G3); *(u32x2*)(base + (size_t)c * LST_TILE) = o;
            float dec = rdec, fac = 1.0f;
            if (grp) { const float Bt = CHK[(bh * 16 + c) * 2], Am = CHK[(bh * 16 + c) * 2 + 1]; const float Ml = fmaxf(m, Am); dec = __expf(m - Ml); fac = __expf(Am - Ml); m = Bt + Ml; }
            const float l0 = __uint_as_float(Lv[c][0] << 16), l1 = __uint_as_float(Lv[c][0] & 0xffff0000u), l2 = __uint_as_float(Lv[c][1] << 16), l3 = __uint_as_float(Lv[c][1] & 0xffff0000u);
            G0 = dec * G0 + fac * l0; G1 = dec * G1 + fac * l1; G2 = dec * G2 + fac * l2; G3 = dec * G3 + fac * l3;
        }
        if (grp == 0) { float* So = A.out + O_SP + (size_t)bh * 16384; So[(d4 + 0) * 128 + row] = G0; So[(d4 + 1) * 128 + row] = G1; So[(d4 + 2) * 128 + row] = G2; So[(d4 + 3) * 128 + row] = G3; }
        else if (row < 128) *(f32x4*)(A.out + O_CP + (size_t)bh * 16384 + row * 128 + d4) = (f32x4){G0, G1, G2, G3};
        else { *(f32x4*)(A.out + O_NP + bh * 128 + d4) = (f32x4){G0, G1, G2, G3}; if (d4 == 0) A.out[O_MP + bh] = m; }
    }
}

__device__ void out_unit(const Args& A, LAS unsigned char* lds, int seq, int c) {
    const int tid = threadIdx.x, lane = tid & 63, w = __builtin_amdgcn_readfirstlane(tid >> 6);
    const int grp = seq >> 5, b = (seq >> 2) & 7, h = seq & 3, t0 = b * 2048 + c * 128, bh = b * 4 + h;
    LAS float* misc = (LAS float*)(lds + MISC_OFF);
    const float lg2g = log2f(1.0f - exp2f(-5.0f - (float)h));
    const float* GA = (const float*)(A.ws + WS_GA); const float* GCM = (const float*)(A.ws + WS_GCM); const float* GB = (const float*)(A.ws + WS_GB); const float* CHK = (const float*)(A.ws + WS_CHK);
    const bf16_t* L = (const bf16_t*)(A.ws + WS_LST) + (size_t)(seq * 16 + c) * LST_TILE;
    float m_prev = -1e30f;
    if (grp) for (int cc = 0; cc < c; ++cc) m_prev = CHK[(bh * 16 + cc) * 2] + fmaxf(m_prev, CHK[(bh * 16 + cc) * 2 + 1]);
    if (tid < 128) {
        float av = 0.f, cv = 0.f, bv = 0.f;
        if (grp) { const size_t o = (size_t)(t0 + tid) * 4 + h; av = GA[o]; cv = GCM[o]; bv = GB[o]; }
        misc[128 + tid] = av; misc[256 + tid] = cv; misc[384 + tid] = bv;
        if (tid < 64) ((LAS unsigned*)(misc + 512))[tid] = grp ? ((const unsigned*)(L + 128 * 128))[tid] : 0u;
    }
    const bf16_t* PROJ = (const bf16_t*)(A.ws + WS_PROJ) + (size_t)t0 * NPROJ;
    const float* RC = (const float*)(A.ws + WS_RC); const float* RS = (const float*)(A.ws + WS_RS);
    LAS unsigned char* TQ = lds; LAS unsigned char* TK = lds + 32768; LAS unsigned char* TV = lds + 65536; LAS unsigned char* TG = lds + 98304;
    const float kscale = 0.08838834764831845f;
    const int qc = (grp ? 2048 : 0) + h * 128, kc = (grp ? 2560 : 512) + h * 128, vc = (grp ? 3072 : 1024) + h * 128;
    if (grp == 0) { fill_bf16<true>(TQ, PROJ + qc, NPROJ, 128, 128, c * 128, RC, RS, 1.0f, nullptr); fill_bf16<true>(TK, PROJ + kc, NPROJ, 128, 128, c * 128, RC, RS, kscale, nullptr); }
    else { fill_bf16<false>(TQ, PROJ + qc, NPROJ, 128, 128, 0, RC, RS, 1.0f, nullptr); fill_bf16<false>(TK, PROJ + kc, NPROJ, 128, 128, 0, RC, RS, kscale, nullptr); }
    fill_bf16<false>(TV, PROJ + vc, NPROJ, 128, 128, 0, RC, RS, 1.0f, nullptr);
    fill_copy(TG, L);
    __syncthreads();
    if (grp) out_wave<1, false>(A, TQ, TK, TV, TG, misc, m_prev, lg2g, w, lane, t0, 128, h); else out_wave<0, false>(A, TQ, TK, TV, TG, misc, 0.f, lg2g, w, lane, t0, 128, h);
    __syncthreads();
}
__device__ void phase_out_units(const Args& A, LAS unsigned char* lds) { for (int u = blockIdx.x; u < 1024; u += gridDim.x) out_unit(A, lds, u >> 4, u & 15); }

__device__ void phase_norm(const Args& A) {
    const int lane = threadIdx.x & 63, wid = threadIdx.x >> 6;
    const float* MIXO = (const float*)(A.ws + WS_MIXO); float* X1 = (float*)(A.ws + WS_X1); bf16_t* H2 = (bf16_t*)(A.ws + WS_H2);
    for (int r = blockIdx.x * 8 + wid; r < T_ALL; r += gridDim.x * 8) {
        const float* x = xrow(A, r); const float* mo = MIXO + (size_t)r * DM; f32x4 v[4]; float ss = 0.f;
#pragma unroll
        for (int q = 0; q < 4; ++q) { v[q] = *(const f32x4*)(mo + q * 256 + lane * 4); ss += v[q][0] * v[q][0] + v[q][1] * v[q][1] + v[q][2] * v[q][2] + v[q][3] * v[q][3]; }
        ss = wave_sum(ss); const float rstd = rsqrtf(ss * (1.0f / 1024.0f) + 1e-6f); float s2 = 0.f;
#pragma unroll
        for (int q = 0; q < 4; ++q) { const f32x4 gp = *(const f32x4*)(A.in[13] + q * 256 + lane * 4); const f32x4 xv = *(const f32x4*)(x + q * 256 + lane * 4);
            v[q] = xv + v[q] * rstd * gp; *(f32x4*)(X1 + (size_t)r * DM + q * 256 + lane * 4) = v[q]; s2 += v[q][0] * v[q][0] + v[q][1] * v[q][1] + v[q][2] * v[q][2] + v[q][3] * v[q][3]; }
        s2 = wave_sum(s2); const float rstd2 = rsqrtf(s2 * (1.0f / 1024.0f) + 1e-6f);
#pragma unroll
        for (int q = 0; q < 4; ++q) { const f32x4 gp = *(const f32x4*)(A.in[14] + q * 256 + lane * 4); const f32x4 hh = v[q] * rstd2 * gp;
            u32x2 w; w[0] = pk2(hh[0], hh[1]); w[1] = pk2(hh[2], hh[3]); *(u32x2*)(H2 + (size_t)r * DM + q * 256 + lane * 4) = w; }
    }
}

__device__ __forceinline__ float gelu_tanh(float x) { const float y = x + 0.044715f * x * x * x; return x * __builtin_amdgcn_rcpf(1.0f + __builtin_amdgcn_exp2f(-2.302208198f * y)); }
__device__ __forceinline__ float dpp_ror1(float v) { return __int_as_float(__builtin_amdgcn_update_dpp(0, __float_as_int(v), 0x121, 0xf, 0xf, false)); }
__device__ __forceinline__ float dpp_ror2(float v) { return __int_as_float(__builtin_amdgcn_update_dpp(0, __float_as_int(v), 0x122, 0xf, 0xf, false)); }

struct EpiConv {
    static constexpr bool PERM = false, AFTER_DRAIN = false;
    bf16_t* act; float* edge; float* head; const float* cw; const float* cb; const float* cache; float* convs;
    __device__ __forceinline__ void operator()(const f32x4 (&acc)[2][2][4][2], const pg8::Unit& u, int wr, int wc, int fr, int fq) const {
        const bool sample = u.pm >= 64;
#pragma unroll
        for (int n = 0; n < 2; ++n) {
            const int j0 = 128 * u.pn + 32 * wc + 16 * n + 4 * fq;
            const f32x4 w0g = *(const f32x4*)(cw + j0), w1g = *(const f32x4*)(cw + NUP + j0), w2g = *(const f32x4*)(cw + 2 * NUP + j0), bg = *(const f32x4*)(cb + j0);
            const f32x4 w0v = *(const f32x4*)(cw + DFF + j0), w1v = *(const f32x4*)(cw + NUP + DFF + j0), w2v = *(const f32x4*)(cw + 2 * NUP + DFF + j0), bv = *(const f32x4*)(cb + DFF + j0);
#pragma unroll
            for (int ai = 0; ai < 2; ++ai)
#pragma unroll
                for (int m = 0; m < 4; ++m) {
                    const int r = u.pm * 256 + ai * 128 + wr * 64 + m * 16 + fr;
                    const f32x4 cg_ = acc[ai][0][m][n], cv_ = acc[ai][1][m][n];
                    f32x4 p1g, p2g, p1v, p2v; bool writeact = true;
                    if (!sample) {
                        f32x4 x1g = cg_, x2g = cg_, x1v = cv_, x2v = cv_;
                        if (m > 0) { const f32x4 pg_ = acc[ai][0][m > 0 ? m - 1 : 0][n], pv_ = acc[ai][1][m > 0 ? m - 1 : 0][n];
                            if (fr == 15) { x1g = pg_; x1v = pv_; } if (fr >= 14) { x2g = pg_; x2v = pv_; } }
#pragma unroll
                        for (int e = 0; e < 4; ++e) { p1g[e] = dpp_ror1(x1g[e]); p2g[e] = dpp_ror2(x2g[e]); p1v[e] = dpp_ror1(x1v[e]); p2v[e] = dpp_ror2(x2v[e]); }
                        const int G64 = r >> 6;
                        if (m == 0 && fr < 2) { writeact = false; float* hp = head + ((size_t)G64 * 2 + fr) * NUP + j0; *(f32x4*)hp = cg_; *(f32x4*)(hp + DFF) = cv_; }
                        if (m == 3 && fr >= 14) { float* ep = edge + ((size_t)G64 * 2 + (fr - 14)) * NUP + j0; *(f32x4*)ep = cg_; *(f32x4*)(ep + DFF) = cv_; }
                    } else {
#pragma unroll
                        for (int e = 0; e < 4; ++e) { p1g[e] = dpp_ror1(cg_[e]); p2g[e] = dpp_ror2(cg_[e]); p1v[e] = dpp_ror1(cv_[e]); p2v[e] = dpp_ror2(cv_[e]); }
                        const int sq = fr & 7, bb = (r - T_P) >> 3;
                        if (sq < 2) { const float* c0 = cache + (size_t)bb * 2 * NUP + j0; const f32x4 k0g = *(const f32x4*)c0, k0v = *(const f32x4*)(c0 + DFF), k1g = *(const f32x4*)(c0 + NUP), k1v = *(const f32x4*)(c0 + NUP + DFF);
                            if (sq == 0) { p2g = k0g; p2v = k0v; p1g = k1g; p1v = k1v; } else { p2g = k1g; p2v = k1v; } }
                        if (sq >= 6) { float* op = convs + ((size_t)bb * 2 + (sq - 6)) * NUP + j0; *(f32x4*)op = cg_; *(f32x4*)(op + DFF) = cv_; }
                    }
                    if (writeact) {
                        const f32x4 yg = w0g * p2g + w1g * p1g + w2g * cg_ + bg, yv = w0v * p2v + w1v * p1v + w2v * cv_ + bv;
                        u32x2 o; o[0] = pk2(gelu_tanh(yg[0]) * yv[0], gelu_tanh(yg[1]) * yv[1]); o[1] = pk2(gelu_tanh(yg[2]) * yv[2], gelu_tanh(yg[3]) * yv[3]);
                        *(u32x2*)(act + (size_t)r * DFF + j0) = o;
                    }
                }
        }
    }
};

__device__ void phase_conv_fixup(const Args& A) {
    const float* edge = (const float*)(A.ws + WS_EDGE); const float* head = (const float*)(A.ws + WS_HEAD); bf16_t* act = (bf16_t*)(A.ws + WS_ACT);
    const float* cw = A.in[16]; const float* cb = A.in[17];
    for (int idx = blockIdx.x * 512 + threadIdx.x; idx < 256 * 2 * 704; idx += gridDim.x * 512) {
        const int j0 = (idx % 704) * 4, rho = (idx / 704) & 1, G = idx / 1408;
        const float* hp = head + ((size_t)G * 2 + rho) * NUP + j0; const f32x4 cg_ = *(const f32x4*)hp, cv_ = *(const f32x4*)(hp + DFF);
        f32x4 p1g = {0.f, 0.f, 0.f, 0.f}, p2g = p1g, p1v = p1g, p2v = p1g;
        if ((G & 31) != 0) {
            const float* e0 = edge + ((size_t)(G - 1) * 2) * NUP + j0; const float* e1 = e0 + NUP;
            if (rho == 0) { p2g = *(const f32x4*)e0; p2v = *(const f32x4*)(e0 + DFF); p1g = *(const f32x4*)e1; p1v = *(const f32x4*)(e1 + DFF); }
            else { p2g = *(const f32x4*)e1; p2v = *(const f32x4*)(e1 + DFF); }
        }
        if (rho == 1) { const float* h0 = head + ((size_t)G * 2) * NUP + j0; p1g = *(const f32x4*)h0; p1v = *(const f32x4*)(h0 + DFF); }
        const f32x4 w0g = *(const f32x4*)(cw + j0), w1g = *(const f32x4*)(cw + NUP + j0), w2g = *(const f32x4*)(cw + 2 * NUP + j0), bg = *(const f32x4*)(cb + j0);
        const f32x4 w0v = *(const f32x4*)(cw + DFF + j0), w1v = *(const f32x4*)(cw + NUP + DFF + j0), w2v = *(const f32x4*)(cw + 2 * NUP + DFF + j0), bv = *(const f32x4*)(cb + DFF + j0);
        const f32x4 yg = w0g * p2g + w1g * p1g + w2g * cg_ + bg, yv = w0v * p2v + w1v * p1v + w2v * cv_ + bv;
        u32x2 o; o[0] = pk2(gelu_tanh(yg[0]) * yv[0], gelu_tanh(yg[1]) * yv[1]); o[1] = pk2(gelu_tanh(yg[2]) * yv[2], gelu_tanh(yg[3]) * yv[3]);
        *(u32x2*)(act + (size_t)(G * 64 + rho) * DFF + j0) = o;
    }
    for (int idx = blockIdx.x * 512 + threadIdx.x; idx < 8 * 2 * 1408; idx += gridDim.x * 512) {
        const int c4 = (idx % 1408) * 4, rho = (idx / 1408) & 1, b = idx / 2816;
        *(f32x4*)(A.out + O_BP + ((size_t)b * 2 + rho) * NUP + c4) = *(const f32x4*)(edge + ((size_t)(b * 32 + 31) * 2 + rho) * NUP + c4);
    }
}

__device__ void phase_final(const Args& A) {
    const int lane = threadIdx.x & 63, wid = threadIdx.x >> 6;
    const float* X1 = (const float*)(A.ws + WS_X1);
    for (int r = blockIdx.x * 8 + wid; r < T_ALL; r += gridDim.x * 8) {
        float* y = A.out + (size_t)r * DM; f32x4 v[4]; float ss = 0.f;
#pragma unroll
        for (int q = 0; q < 4; ++q) { v[q] = *(const f32x4*)(y + q * 256 + lane * 4); ss += v[q][0] * v[q][0] + v[q][1] * v[q][1] + v[q][2] * v[q][2] + v[q][3] * v[q][3]; }
        ss = wave_sum(ss); const float rstd = rsqrtf(ss * (1.0f / 1024.0f) + 1e-6f);
#pragma unroll
        for (int q = 0; q < 4; ++q) { const f32x4 gp = *(const f32x4*)(A.in[19] + q * 256 + lane * 4); const f32x4 xv = *(const f32x4*)(X1 + (size_t)r * DM + q * 256 + lane * 4);
            *(f32x4*)(y + q * 256 + lane * 4) = xv + v[q] * rstd * gp; }
    }
}

template <class Epi>
__device__ __forceinline__ void run_gemm(LAS unsigned char* lds, const bf16_t* Am, const bf16_t* Bt, int N, int K, const Epi& E) {
    pg8::Gemm g; g.A = Am; g.Bt = Bt; g.M = T_ALL; g.N = N; g.K = K;
    pg8::StaticOrder S; S.init(T_ALL, N, (int)gridDim.x, (int)blockIdx.x);
    pg8::gemm_phase<Epi, pg8::StaticOrder, false>(lds, g, S, E, nullptr);
    __syncthreads();
}

#ifndef PH_LO
#define PH_LO 0
#define PH_HI 99
#endif

#define XB_TMO      128
#define XB_XCNT(j)  (256  + 64 * (j))
#define XB_XSUB(j)  (1280 + 64 * (j))
#define XB_XGEN(j)  (2304 + 64 * (j))
#define XB_TOP      3328
#define XB_TOPGEN   3392
#define XCD_BAR_WORDS 3456
#define XB_SPIN_CAP (1u << 18)
__device__ __forceinline__ unsigned xb_ld(unsigned* p)              { return __hip_atomic_load(p, __ATOMIC_RELAXED, __HIP_MEMORY_SCOPE_AGENT); }
__device__ __forceinline__ unsigned xb_add(unsigned* p, unsigned v) { return __hip_atomic_fetch_add(p, v, __ATOMIC_RELAXED, __HIP_MEMORY_SCOPE_AGENT); }
__device__ __forceinline__ unsigned xb_xcc_id() { return (unsigned)__builtin_amdgcn_s_getreg((3 << 11) | 20) & 0xFu; }
#define XB_SPIN(cond, bar) do { unsigned _sp = 0; while (cond) { __builtin_amdgcn_s_sleep(1); \
    if ((++_sp & 255u) == 0u) { if (xb_ld(&(bar)[XB_TMO])) break; if (_sp > XB_SPIN_CAP) { atomicAdd(&(bar)[XB_TMO], 1u); break; } } } } while (0)
struct XcdBarrier { unsigned* bar; unsigned x; volatile LAS unsigned* st; };
__device__ __forceinline__ XcdBarrier xcd_barrier_post(unsigned* bar, volatile LAS unsigned* st) {
    XcdBarrier b; b.bar = bar; b.x = xb_xcc_id(); b.st = st;
    if (threadIdx.x == 0) (void)xb_add(&bar[XB_XCNT(b.x)], 1u);
    return b;
}
__device__ __forceinline__ void xcd_barrier_complete(unsigned* bar, unsigned x, unsigned& nloc, unsigned& nx) {
    const unsigned G = gridDim.x * gridDim.y * gridDim.z;
    unsigned sum, cnt, mine, sp = 0u;
    for (;;) {
        sum = 0u; cnt = 0u; mine = 0u;
#pragma unroll
        for (unsigned j = 0; j < 16; ++j) { const unsigned c = xb_ld(&bar[XB_XCNT(j)]); sum += c; cnt += (c > 0u) ? 1u : 0u; mine = (j == x) ? c : mine; }
        if (sum == G) break;
        __builtin_amdgcn_s_sleep(1);
        if ((++sp & 255u) == 0u) { if (xb_ld(&bar[XB_TMO])) break; if (sp > XB_SPIN_CAP) { atomicAdd(&bar[XB_TMO], 1u); break; } }
    }
    nloc = mine > 0u ? mine : 1u; nx = cnt > 0u ? cnt : 1u;
}
__device__ __forceinline__ void xcd_barrier(const XcdBarrier& b) {
    asm volatile("s_waitcnt vmcnt(0)" ::: "memory");
    __syncthreads();
    if (threadIdx.x == 0) {
        unsigned* bar = b.bar;
        __builtin_amdgcn_s_waitcnt(0);
        unsigned nloc = b.st[0], nx = b.st[1];
        if (nloc == 0u) { xcd_barrier_complete(bar, b.x, nloc, nx); b.st[0] = nloc; b.st[1] = nx; }
        const unsigned old = xb_add(&bar[XB_XSUB(b.x)], 1u);
        const unsigned gen = old / nloc;
        if (old + 1u == (gen + 1u) * nloc) {
            __builtin_amdgcn_fence(__ATOMIC_RELEASE, "agent");
            asm volatile("s_waitcnt vmcnt(0)" ::: "memory");
            const unsigned og = xb_add(&bar[XB_TOP], 1u);
            const unsigned tg = og / nx;
            if (og + 1u == (tg + 1u) * nx) xb_add(&bar[XB_TOPGEN], 1u);
            else XB_SPIN(xb_ld(&bar[XB_TOPGEN]) == tg, bar);
            __builtin_amdgcn_fence(__ATOMIC_ACQUIRE, "agent");
            xb_add(&bar[XB_XGEN(b.x)], 1u);
            asm volatile("s_waitcnt vmcnt(0)" ::: "memory");
        } else {
            XB_SPIN(xb_ld(&bar[XB_XGEN(b.x)]) == gen, bar);
            __builtin_amdgcn_fence(__ATOMIC_ACQUIRE, "agent");
            asm volatile("s_waitcnt vmcnt(0)" ::: "memory");
        }
    }
    __syncthreads();
}

#ifndef DUPMASK
#define DUPMASK 0
#endif
#ifndef EXTRA_SYNCS
#define EXTRA_SYNCS 0
#endif
#define NREP(bit) ((DUPMASK & (bit)) ? 2 : 1)
__global__ void __launch_bounds__(512) fwd_kernel(Args A) {
    extern __shared__ __attribute__((aligned(16))) unsigned char shm[];
    LAS unsigned char* lds = (LAS unsigned char*)shm;
    cg::grid_group grid = cg::this_grid();
    if (A.out == nullptr) grid.sync();
    if (threadIdx.x < 4) ((LAS unsigned*)(lds + MISC_OFF + 3072))[threadIdx.x] = 0u;
    __syncthreads();
    const XcdBarrier xb = xcd_barrier_post((unsigned*)(A.ws + WS_BAR), (volatile LAS unsigned*)(lds + MISC_OFF + 3072));
#pragma unroll 1
    for (int rp = 0; rp < NREP(1); ++rp) { phase_convert_weights(A, lds); phase_prep_rows(A); phase_rope_table(A); }
    xcd_barrier(xb);
    phase_gate_scan(A);
#pragma unroll 1
    for (int rp = 0; rp < NREP(4); ++rp) { pg8::EpiBf16<0> E; E.O = (bf16_t*)(A.ws + WS_PROJ); E.ldc = NPROJ; E.bias = nullptr; E.split_cols = 0; E.split_stride = 0;
      run_gemm(lds, (const bf16_t*)(A.ws + WS_H), (const bf16_t*)(A.ws + WS_WIN), NPROJ, 1024, E); }
    xcd_barrier(xb);
#pragma unroll 1
    for (int rp = 0; rp < NREP(8); ++rp) phase_local_and_sample(A, lds);
    xcd_barrier(xb);
    phase_scan(A);
    xcd_barrier(xb);
#pragma unroll 1
    for (int rp = 0; rp < NREP(32); ++rp) phase_out_units(A, lds);
    xcd_barrier(xb);
#pragma unroll 1
    for (int rp = 0; rp < NREP(64); ++rp) { pg8::EpiF32 E; E.C = (float*)(A.ws + WS_MIXO); E.ldc = DM; E.bias = nullptr; run_gemm(lds, (const bf16_t*)(A.ws + WS_MIXIN), (const bf16_t*)(A.ws + WS_WOUT), 1024, 1024, E); }
    xcd_barrier(xb);
#pragma unroll 1
    for (int rp = 0; rp < NREP(128); ++rp) phase_norm(A);
    xcd_barrier(xb);
#pragma unroll 1
    for (int rp = 0; rp < NREP(256); ++rp) { EpiConv E; E.act = (bf16_t*)(A.ws + WS_ACT); E.edge = (float*)(A.ws + WS_EDGE); E.head = (float*)(A.ws + WS_HEAD); E.cw = A.in[16]; E.cb = A.in[17]; E.cache = A.in[6]; E.convs = A.out + O_BS;
      run_gemm(lds, (const bf16_t*)(A.ws + WS_H2), (const bf16_t*)(A.ws + WS_WUP), NUP, 1024, E); }
    xcd_barrier(xb);
    phase_conv_fixup(A);
    xcd_barrier(xb);
#pragma unroll 1
    for (int rp = 0; rp < NREP(1024); ++rp) { pg8::EpiF32 E; E.C = A.out + O_Y; E.ldc = DM; E.bias = nullptr; run_gemm(lds, (const bf16_t*)(A.ws + WS_ACT), (const bf16_t*)(A.ws + WS_WDOWN), 1024, DFF, E); }
    xcd_barrier(xb);
    phase_final(A);
#pragma unroll 1
    for (int rp = 0; rp < EXTRA_SYNCS; ++rp) xcd_barrier(xb);
}

extern "C" void kernel_launch(void* const* d_in, const int* in_sizes, int n_in, void* d_out, int out_size, void* d_ws, size_t ws_size, hipStream_t stream) {
    static int grid = 0;
    if (grid == 0) {
        int dev = 0, cus = 0, per_cu = 0;
        hipGetDevice(&dev); hipDeviceGetAttribute(&cus, hipDeviceAttributeMultiprocessorCount, dev);
        hipFuncSetAttribute((const void*)fwd_kernel, hipFuncAttributeMaxDynamicSharedMemorySize, LDS_BYTES);
        hipOccupancyMaxActiveBlocksPerMultiprocessor(&per_cu, (const void*)fwd_kernel, 512, LDS_BYTES);
        if (per_cu < 1) per_cu = 1;
        if (per_cu > 1) per_cu = 1;
        grid = cus * per_cu; (void)hipGetLastError();
        if (ws_size < 256 * MiB) fprintf(stderr, "kernel_launch: workspace too small (%zu)\n", ws_size);
    }
    Args a{};
    for (int i = 0; i < 20; ++i) a.in[i] = (const float*)d_in[i];
    a.out = (float*)d_out; a.ws = (unsigned char*)d_ws;
    (void)hipMemsetAsync((unsigned char*)d_ws + WS_BAR, 0, XCD_BAR_WORDS * 4, stream);
    void* args[] = {&a};
    hipError_t e = hipLaunchCooperativeKernel((const void*)fwd_kernel, dim3(grid), dim3(512), args, LDS_BYTES, stream);
    if (e != hipSuccess) fprintf(stderr, "cooperative launch failed: %s (grid %d)\n", hipGetErrorString(e), grid);
}
```

```cpp
#define DUPMASK 0
#define EXTRA_SYNCS 0
#include <hip/hip_runtime.h>
#include <hip/hip_cooperative_groups.h>
#include <cstdio>
namespace cg = cooperative_groups;
namespace pg8 {
#define PG8_LAS __attribute__((address_space(3)))
typedef unsigned short bf16_t;
typedef short bf16x8 __attribute__((ext_vector_type(8)));
typedef float f32x4 __attribute__((ext_vector_type(4)));
typedef unsigned u32x4 __attribute__((ext_vector_type(4)));
constexpr int BM = 256, BK = 64, HALF = 128, HTB = HALF * BK * 2  , STAGE_BYTES = 8 * HTB, NXCD = 8, WGM = 8;

__host__ __device__ __forceinline__ int lds_byte(int r, int c) { const int st = (r >> 4) * 2 + (c >> 5), rr = r & 15, cc = c & 31, ob = rr * 64 + cc * 2; return st * 1024 + (ob ^ (((ob >> 9) & 1) << 5)); }
__host__ __device__ __forceinline__ void stage_rc(int b, int& R, int& C) { const int st = b / 1024, sb = b % 1024, swz = sb ^ (((sb >> 9) & 1) << 5); R = (st >> 1) * 16 + swz / 64; C = (st & 1) * 32 + (swz % 64) / 2; }
__host__ __device__ __forceinline__ int perm32(int rho) { const int n = rho >> 4, i = rho & 15; return 8 * (i >> 2) + 4 * n + (i & 3); }

struct Unit { int pm, pn; };
struct Gemm { const bf16_t* A; const bf16_t* Bt; int M, N, K; };

struct StaticOrder {
    int nM, nN, nwg, G, c;
    __host__ __device__ void init(int M, int N, int G_, int c_) { nM = M / BM; nN = N / BM; nwg = nM * nN; G = G_; c = c_; }
    __host__ __device__ bool next(int i, Unit& u) const {
        const long L = (long)i * G + c; if (L >= nwg) return false;
        int wgid = (int)L; { const int q = nwg / NXCD, r = nwg % NXCD, xcd = wgid % NXCD, off = wgid / NXCD; wgid = (xcd < r ? xcd * (q + 1) : r * (q + 1) + (xcd - r) * q) + off; }
        const int nig = WGM * nN, gid = wgid / nig, fm = gid * WGM, gsz = (nM - fm) < WGM ? (nM - fm) : WGM;
        u.pm = fm + ((wgid % nig) % gsz); u.pn = (wgid % nig) / gsz; return true;
    }
    __device__ __forceinline__ void a_ready(const Unit&) const {}
    __device__ __forceinline__ void done(const Unit&) const {}
};
struct CountedOrder : StaticOrder {
    const unsigned* ready; unsigned need; unsigned* tmo;
    __device__ __forceinline__ void a_ready(const Unit& u) const {
        if (threadIdx.x < 64) {
            const unsigned long long t0 = __builtin_amdgcn_s_memrealtime(); unsigned polls = 0;
            while ((unsigned)__builtin_amdgcn_readfirstlane(__hip_atomic_load(ready + 64 * u.pm, __ATOMIC_RELAXED, __HIP_MEMORY_SCOPE_AGENT)) < need) {
                if ((++polls & 255u) == 0u && __builtin_amdgcn_readfirstlane(__hip_atomic_load(tmo, __ATOMIC_RELAXED, __HIP_MEMORY_SCOPE_AGENT)) != 0u) break;
                if (__builtin_amdgcn_s_memrealtime() - t0 > 2000000ull) {
                    if (threadIdx.x == 0) { unsigned expect = 0u; __hip_atomic_compare_exchange_strong(tmo + 1, &expect, 0x600u | (unsigned)(u.pm & 0xff), __ATOMIC_RELAXED, __ATOMIC_RELAXED, __HIP_MEMORY_SCOPE_AGENT); __hip_atomic_store(tmo, 1u, __ATOMIC_RELAXED, __HIP_MEMORY_SCOPE_AGENT); }
                    break; }
                __builtin_amdgcn_s_sleep(2); }
            __builtin_amdgcn_fence(__ATOMIC_ACQUIRE, "agent");
            asm volatile("s_waitcnt vmcnt(0)" ::: "memory");
        }
#if !defined(BROKEN_HOOK_NO_BARRIER)
        asm volatile("" ::: "memory"); __builtin_amdgcn_s_barrier(); asm volatile("" ::: "memory");
#endif
    }
};

__device__ __forceinline__ unsigned cvt_pk_bf16(float lo, float hi) { unsigned r; asm volatile("v_cvt_pk_bf16_f32 %0, %1, %2" : "=v"(r) : "v"(lo), "v"(hi)); return r; }
typedef float f32x2 __attribute__((ext_vector_type(2)));
__device__ __forceinline__ f32x2 gelu_pk(f32x2 v) {
    const f32x2 av = __builtin_elementwise_abs(v), d = av * 0.2316418882f + 1.0f;
    f32x2 t; t.x = __builtin_amdgcn_rcpf(d.x); t.y = __builtin_amdgcn_rcpf(d.y);
    f32x2 q = t * 0.5307027145f + (-0.7265760135f); q = q * t + 0.7107068705f; q = q * t + (-0.142248368f); q = q * t + 0.127414796f; q = q * t;
    const f32x2 s = (v * v) * (-0.72134752044f);
    f32x2 e; e.x = __builtin_amdgcn_exp2f(s.x); e.y = __builtin_amdgcn_exp2f(s.y);
    const f32x2 m = v * (q * e), r = v - m;
    f32x2 o; o.x = v.x < 0.f ? m.x : r.x; o.y = v.y < 0.f ? m.y : r.y; return o;
}

struct EpiF32 {
    static constexpr bool PERM = false, AFTER_DRAIN = false;
    float* C; int ldc; const float* bias;
    __device__ __forceinline__ void operator()(const f32x4 (&acc)[2][2][4][2], const Unit& u, int wr, int wc, int fr, int fq) const {
        const int row0 = u.pm * BM + wr * 64 + fr, col0 = u.pn * BM + wc * 32 + 4 * fq;
        f32x4 bv[2][2];
#pragma unroll
        for (int bj = 0; bj < 2; ++bj)
#pragma unroll
            for (int n = 0; n < 2; ++n) bv[bj][n] = bias ? *(const f32x4*)(bias + col0 + bj * HALF + n * 16) : (f32x4){0.f, 0.f, 0.f, 0.f};
#pragma unroll
        for (int ai = 0; ai < 2; ++ai)
#pragma unroll
            for (int m = 0; m < 4; ++m) { float* rowp = C + (size_t)(row0 + ai * HALF + m * 16) * ldc + col0;
#pragma unroll
                for (int bj = 0; bj < 2; ++bj)
#pragma unroll
                    for (int n = 0; n < 2; ++n) *(f32x4*)(rowp + bj * HALF + n * 16) = acc[ai][bj][m][n] + bv[bj][n]; }
    }
};
template <int ACT  > struct EpiBf16 {
    static constexpr bool PERM = true, AFTER_DRAIN = false;
    bf16_t* O; int ldc; const float* bias; int split_cols; size_t split_stride;
    __device__ __forceinline__ void operator()(const f32x4 (&acc)[2][2][4][2], const Unit& u, int wr, int wc, int fr, int fq) const {
        const int row0 = u.pm * BM + wr * 64 + fr; int colt = u.pn * BM; bf16_t* base = O;
        if (split_cols) { const int t = colt / split_cols; base += (size_t)t * split_stride; colt -= t * split_cols; }
        const int col0 = colt + wc * 32 + 8 * fq, bcol0 = u.pn * BM + wc * 32 + 8 * fq;
        f32x4 bv[2][2];
#pragma unroll
        for (int bj = 0; bj < 2; ++bj)
#pragma unroll
            for (int n = 0; n < 2; ++n) bv[bj][n] = bias ? *(const f32x4*)(bias + bcol0 + bj * HALF + 4 * n) : (f32x4){0.f, 0.f, 0.f, 0.f};
#pragma unroll
        for (int ai = 0; ai < 2; ++ai)
#pragma unroll
            for (int m = 0; m < 4; ++m) { bf16_t* rowp = base + (size_t)(row0 + ai * HALF + m * 16) * ldc + col0;
#pragma unroll
                for (int bj = 0; bj < 2; ++bj) { f32x4 v0 = acc[ai][bj][m][0] + bv[bj][0], v1 = acc[ai][bj][m][1] + bv[bj][1];
                    if (ACT == 1) { f32x2 a = gelu_pk((f32x2){v0[0], v0[1]}), b = gelu_pk((f32x2){v0[2], v0[3]}), c = gelu_pk((f32x2){v1[0], v1[1]}), d = gelu_pk((f32x2){v1[2], v1[3]});
                        v0 = (f32x4){a.x, a.y, b.x, b.y}; v1 = (f32x4){c.x, c.y, d.x, d.y}; }
                    if (ACT == 2) {
#pragma unroll
                        for (int j = 0; j < 4; ++j) { v0[j] = 0.5f * v0[j] * (1.0f + erff(v0[j] * 0.70710678f)); v1[j] = 0.5f * v1[j] * (1.0f + erff(v1[j] * 0.70710678f)); } }
                    u32x4 w; w.x = cvt_pk_bf16(v0[0], v0[1]); w.y = cvt_pk_bf16(v0[2], v0[3]); w.z = cvt_pk_bf16(v1[0], v1[1]); w.w = cvt_pk_bf16(v1[2], v1[3]);
                    *(u32x4*)(rowp + bj * HALF) = w; } }
    }
};

struct PanelStats {
    unsigned* xbuf;
    unsigned* cnt;
    unsigned* tmo;
    int ntn; float eps;
    unsigned code;
    __device__ __forceinline__ bool run(const f32x4 (&v)[2][2][4][2], const Unit& u, int wr, int wc, int fr, int fq, PG8_LAS unsigned char* lds, int wid, int lane) const {
        typedef float f32x2v __attribute__((ext_vector_type(2)));
        PG8_LAS f32x2v* P = (PG8_LAS f32x2v*)lds;
        PG8_LAS f32x2v* S = (PG8_LAS f32x2v*)(lds + 8192);
        PG8_LAS unsigned* flag = (PG8_LAS unsigned*)(lds + 8192 + 2048);
#pragma unroll
        for (int ai = 0; ai < 2; ++ai)
#pragma unroll
            for (int m = 0; m < 4; ++m) {
                float s = 0.f;
#pragma unroll
                for (int bj = 0; bj < 2; ++bj)
#pragma unroll
                    for (int n = 0; n < 2; ++n) { const f32x4 x = v[ai][bj][m][n]; s += (x[0] + x[1]) + (x[2] + x[3]); }
                s += __shfl_xor(s, 16); s += __shfl_xor(s, 32);
                const float mw = s * (1.0f / 64.0f); float q = 0.f;
#pragma unroll
                for (int bj = 0; bj < 2; ++bj)
#pragma unroll
                    for (int n = 0; n < 2; ++n) { const f32x4 d = v[ai][bj][m][n] - mw; q += (d[0] * d[0] + d[1] * d[1]) + (d[2] * d[2] + d[3] * d[3]); }
                q += __shfl_xor(q, 16); q += __shfl_xor(q, 32);
                if (fq == 0) P[(ai * HALF + wr * 64 + m * 16 + fr) * 4 + wc] = (f32x2v){mw, q};
            }
        asm volatile("s_waitcnt lgkmcnt(0)" ::: "memory"); __builtin_amdgcn_s_barrier(); asm volatile("" ::: "memory");
#if defined(BROKEN_NO_WAIT)
        if (blockIdx.x >= 64) { const long long t0 = clock64(); while (clock64() - t0 < 60000) __builtin_amdgcn_s_sleep(8); }
#endif
        const int row = wid * 32 + (lane & 31);
        if (lane < 32) {
            const f32x2v a = P[row * 4 + 0], b = P[row * 4 + 1], c = P[row * 4 + 2], d = P[row * 4 + 3];
            const float mt = (a.x + b.x + c.x + d.x) * 0.25f;
            const float da = a.x - mt, db = b.x - mt, dc = c.x - mt, dd = d.x - mt;
            const float m2 = (a.y + b.y) + (c.y + d.y) + 64.0f * ((da * da + db * db) + (dc * dc + dd * dd));
            unsigned long long* slot = (unsigned long long*)xbuf + ((size_t)(u.pm * BM + row) * 4 + u.pn);
            __hip_atomic_store(slot, ((unsigned long long)__float_as_uint(m2) << 32) | __float_as_uint(mt), __ATOMIC_RELAXED, __HIP_MEMORY_SCOPE_AGENT);
        }
        asm volatile("s_waitcnt vmcnt(0)" ::: "memory");
        if (lane == 0) __hip_atomic_fetch_add(cnt + 64 * u.pm, 1u, __ATOMIC_RELAXED, __HIP_MEMORY_SCOPE_AGENT);
        if (wid == 0) {
            bool dead = false; const unsigned long long t0 = __builtin_amdgcn_s_memrealtime(); const unsigned want = 8u * (unsigned)ntn;
            for (;;) {
#if defined(BROKEN_NO_WAIT)
                break;
#endif
                if ((unsigned)__builtin_amdgcn_readfirstlane(__hip_atomic_load(cnt + 64 * u.pm, __ATOMIC_RELAXED, __HIP_MEMORY_SCOPE_AGENT)) >= want) break;
                if (__builtin_amdgcn_s_memrealtime() - t0 > 2000000ull) {
                    if (lane == 0) { unsigned expect = 0u; __hip_atomic_compare_exchange_strong(tmo + 1, &expect, code | (unsigned)(u.pm & 0xff), __ATOMIC_RELAXED, __ATOMIC_RELAXED, __HIP_MEMORY_SCOPE_AGENT);
                                     __hip_atomic_store(tmo, 1u, __ATOMIC_RELAXED, __HIP_MEMORY_SCOPE_AGENT); }
                    dead = true; break; }
                __builtin_amdgcn_s_sleep(2);
            }
            __builtin_amdgcn_fence(__ATOMIC_ACQUIRE, "agent");
            if (lane == 0) flag[0] = dead ? 1u : 0u;
        }
        asm volatile("s_waitcnt vmcnt(0) lgkmcnt(0)" ::: "memory"); __builtin_amdgcn_s_barrier(); asm volatile("" ::: "memory");
        const bool bad = flag[0] != 0u;
        if (lane < 32) {
            const unsigned long long* slot = (const unsigned long long*)xbuf + (size_t)(u.pm * BM + row) * 4; float mt[4], m2[4]; float ms = 0.f;
#pragma unroll
            for (int t = 0; t < 4; ++t) { if (t < ntn) { const unsigned long long w = __hip_atomic_load(slot + t, __ATOMIC_RELAXED, __HIP_MEMORY_SCOPE_AGENT); mt[t] = __uint_as_float((unsigned)w); m2[t] = __uint_as_float((unsigned)(w >> 32)); } else { mt[t] = 0.f; m2[t] = 0.f; } ms += mt[t]; }
            const float mean = ms / (float)ntn; float q = 0.f;
#pragma unroll
            for (int t = 0; t < 4; ++t) if (t < ntn) { const float dm = mt[t] - mean; q += m2[t] + 256.0f * dm * dm; }
            S[row] = (f32x2v){mean, 1.0f / sqrtf(q / (256.0f * (float)ntn) + eps)};
        }
        asm volatile("s_waitcnt lgkmcnt(0)" ::: "memory"); __builtin_amdgcn_s_barrier(); asm volatile("" ::: "memory");
        return bad;
    }
};
struct EpiLnRes {
    static constexpr bool PERM = false, AFTER_DRAIN = true;
    const float* base; float* out; int ldc; const float* bias; PanelStats st; unsigned poison;
    __device__ __forceinline__ void refuse(size_t i0, size_t stride, int M, int N) const { const float q = __builtin_nanf(""); for (size_t i = i0; i < (size_t)M * N; i += stride) out[(i / N) * ldc + i % N] = q;
        if (i0 == 0) { unsigned expect = 0u; __hip_atomic_compare_exchange_strong(st.tmo + 1, &expect, 0x7f0u, __ATOMIC_RELAXED, __ATOMIC_RELAXED, __HIP_MEMORY_SCOPE_AGENT); __hip_atomic_store(st.tmo, 1u, __ATOMIC_RELAXED, __HIP_MEMORY_SCOPE_AGENT); } }
    __device__ __forceinline__ void fused(f32x4 (&acc)[2][2][4][2], const Unit& u, int wr, int wc, int fr, int fq, PG8_LAS unsigned char* lds, int wid, int lane) const {
        typedef float f32x2v __attribute__((ext_vector_type(2)));
        const PG8_LAS f32x2v* S = (const PG8_LAS f32x2v*)(lds + 8192);
        const int col0 = u.pn * BM + wc * 32 + 4 * fq;
#pragma unroll
        for (int bj = 0; bj < 2; ++bj)
#pragma unroll
            for (int n = 0; n < 2; ++n) { const f32x4 bv = bias ? *(const f32x4*)(bias + col0 + bj * HALF + n * 16) : (f32x4){0.f, 0.f, 0.f, 0.f};
#pragma unroll
                for (int ai = 0; ai < 2; ++ai)
#pragma unroll
                    for (int m = 0; m < 4; ++m) acc[ai][bj][m][n] += bv; }
        const bool bad = st.run(acc, u, wr, wc, fr, fq, lds, wid, lane) || poison != 0u;
        const float qnan = __builtin_nanf("");
#pragma unroll
        for (int ai = 0; ai < 2; ++ai)
#pragma unroll
            for (int m = 0; m < 4; ++m) { const int r = ai * HALF + wr * 64 + m * 16 + fr; const f32x2v sr = S[r]; const size_t off = (size_t)(u.pm * BM + r) * ldc + col0;
#pragma unroll
                for (int bj = 0; bj < 2; ++bj)
#pragma unroll
                    for (int n = 0; n < 2; ++n) { const f32x4 bs = *(const f32x4*)(base + off + bj * HALF + n * 16); f32x4 o = bs + (acc[ai][bj][m][n] - sr.x) * sr.y;
                        if (bad) o = (f32x4){qnan, qnan, qnan, qnan}; *(f32x4*)(out + off + bj * HALF + n * 16) = o; }
                asm volatile("" ::: "memory"); }
    }
};
struct EpiLnResLn {
    static constexpr bool PERM = false, AFTER_DRAIN = true;
    const float* base; float* out; bf16_t* xn; int ldc; const float* bias; PanelStats st1, st2; unsigned poison;
    __device__ __forceinline__ void refuse(size_t i0, size_t stride, int M, int N) const { const float q = __builtin_nanf(""); for (size_t i = i0; i < (size_t)M * N; i += stride) { const size_t o = (i / N) * ldc + i % N; out[o] = q; xn[o] = (bf16_t)0x7fc0u; }
        if (i0 == 0) { unsigned expect = 0u; __hip_atomic_compare_exchange_strong(st1.tmo + 1, &expect, 0x7f0u, __ATOMIC_RELAXED, __ATOMIC_RELAXED, __HIP_MEMORY_SCOPE_AGENT); __hip_atomic_store(st1.tmo, 1u, __ATOMIC_RELAXED, __HIP_MEMORY_SCOPE_AGENT); } }
    __device__ __forceinline__ void fused(f32x4 (&acc)[2][2][4][2], const Unit& u, int wr, int wc, int fr, int fq, PG8_LAS unsigned char* lds, int wid, int lane) const {
        typedef float f32x2v __attribute__((ext_vector_type(2))); typedef unsigned u32x2v __attribute__((ext_vector_type(2)));
        const PG8_LAS f32x2v* S = (const PG8_LAS f32x2v*)(lds + 8192);
        const int col0 = u.pn * BM + wc * 32 + 4 * fq;
#pragma unroll
        for (int bj = 0; bj < 2; ++bj)
#pragma unroll
            for (int n = 0; n < 2; ++n) { const f32x4 bv = bias ? *(const f32x4*)(bias + col0 + bj * HALF + n * 16) : (f32x4){0.f, 0.f, 0.f, 0.f};
#pragma unroll
                for (int ai = 0; ai < 2; ++ai)
#pragma unroll
                    for (int m = 0; m < 4; ++m) acc[ai][bj][m][n] += bv; }
        bool bad = st1.run(acc, u, wr, wc, fr, fq, lds, wid, lane) || poison != 0u;
        const float qnan = __builtin_nanf("");
#pragma unroll
        for (int ai = 0; ai < 2; ++ai)
#pragma unroll
            for (int m = 0; m < 4; ++m) { const int r = ai * HALF + wr * 64 + m * 16 + fr; const f32x2v sr = S[r]; const size_t off = (size_t)(u.pm * BM + r) * ldc + col0;
#pragma unroll
                for (int bj = 0; bj < 2; ++bj)
#pragma unroll
                    for (int n = 0; n < 2; ++n) { const f32x4 bs = *(const f32x4*)(base + off + bj * HALF + n * 16); acc[ai][bj][m][n] = bs + (acc[ai][bj][m][n] - sr.x) * sr.y; }
                asm volatile("" : "+v"(acc[ai][0][m][0]), "+v"(acc[ai][0][m][1]), "+v"(acc[ai][1][m][0]), "+v"(acc[ai][1][m][1]));
                if (m & 1) asm volatile("" ::: "memory"); }
        const bool bad1 = bad;
        bad = st2.run(acc, u, wr, wc, fr, fq, lds, wid, lane) || bad;
#pragma unroll
        for (int ai = 0; ai < 2; ++ai)
#pragma unroll
            for (int m = 0; m < 4; ++m) { const int r = ai * HALF + wr * 64 + m * 16 + fr; const f32x2v sr = S[r]; const size_t off = (size_t)(u.pm * BM + r) * ldc + col0;
#pragma unroll
                for (int bj = 0; bj < 2; ++bj)
#pragma unroll
                    for (int n = 0; n < 2; ++n) { const f32x4 x1 = acc[ai][bj][m][n]; *(f32x4*)(out + off + bj * HALF + n * 16) = bad1 ? (f32x4){qnan, qnan, qnan, qnan} : x1;
                        const f32x4 o = (x1 - sr.x) * sr.y; u32x2v w; w.x = cvt_pk_bf16(o[0], o[1]); w.y = cvt_pk_bf16(o[2], o[3]);
                        if (bad) { w.x = 0x7fc07fc0u; w.y = 0x7fc07fc0u; } *(u32x2v*)(xn + off + bj * HALF + n * 16) = w; }
                asm volatile("" ::: "memory"); }
    }
};

template <class Epi, class Sched, bool STAMP = false>
__device__ __forceinline__ void gemm_phase(PG8_LAS unsigned char* lds, const Gemm g, const Sched& S, const Epi& E, unsigned long long* stamps) {
    int tid_ = threadIdx.x; asm volatile("" : "+v"(tid_));
    const int tid = tid_, wid = __builtin_amdgcn_readfirstlane(tid >> 6), lane = tid & 63, wr = wid >> 2, wc = wid & 3, fr = lane & 15, fq = lane >> 4;
    const int K = g.K, nt = K / BK;
    int ts_lo = 0, ts_hi = 0, nts = 0; const unsigned long long rt_entry = STAMP ? (unsigned long long)wall_clock64() : 0ull;
#define PG8_STAMP() do { if (STAMP && wid == 0 && nts < 64) { const unsigned long long _c = (unsigned long long)clock64(); \
        ts_lo = (lane == nts) ? (int)(unsigned)_c : ts_lo; ts_hi = (lane == nts) ? (int)(unsigned)(_c >> 32) : ts_hi; ++nts; } } while (0)
    PG8_STAMP();
    unsigned voffA[2], voffB[2];
#pragma unroll
    for (int i = 0; i < 2; ++i) { int R, C; stage_rc(tid * 16 + i * 8192, R, C); const int Rb = Epi::PERM ? ((R & ~31) + perm32(R & 31)) : R;
        voffA[i] = (unsigned)(R * K + C) * 2u; voffB[i] = (unsigned)(Rb * K + C) * 2u; }
    const size_t kstep = (size_t)(BK * 2);
    const size_t hstep = (size_t)HALF * K * 2;
    const size_t tstep = 2 * hstep;
    const unsigned ldsw = (unsigned)wid * 1024u;
    const int aoff = lds_byte(wr * 64 + fr, fq * 8), boff = lds_byte(wc * 32 + fr, fq * 8);
#define PG8_SA(b, h) (((b) * 2 + (h)) * HTB)
#define PG8_SB(b, h) ((4 + (b) * 2 + (h)) * HTB)
#define PG8_STAGE(bufoff, gbase, voff) do { _Pragma("unroll") for (int _i = 0; _i < 2; ++_i) \
        __builtin_amdgcn_global_load_lds((const unsigned*)((const char*)(gbase) + (voff)[_i]), (PG8_LAS unsigned*)(lds + (bufoff) + ldsw + _i * 8192), 16, 0, 0); } while (0)
#define PG8_LDA(dst, b, h) do { _Pragma("unroll") for (int m = 0; m < 4; ++m) _Pragma("unroll") for (int k = 0; k < 2; ++k) dst[m][k] = *(const PG8_LAS bf16x8*)(lds + PG8_SA(b, h) + aoff + m * 2048 + k * 1024); } while (0)
#define PG8_LDB(dst, b, h) do { _Pragma("unroll") for (int n = 0; n < 2; ++n) _Pragma("unroll") for (int k = 0; k < 2; ++k) dst[n][k] = *(const PG8_LAS bf16x8*)(lds + PG8_SB(b, h) + boff + n * 2048 + k * 1024); } while (0)
#define PG8_MMA(ai, bj, At, Bt) do { __builtin_amdgcn_s_setprio(1); _Pragma("unroll") for (int m = 0; m < 4; ++m) _Pragma("unroll") for (int n = 0; n < 2; ++n) _Pragma("unroll") for (int k = 0; k < 2; ++k) \
        acc[ai][bj][m][n] = __builtin_amdgcn_mfma_f32_16x16x32_bf16(Bt[n][k], At[m][k], acc[ai][bj][m][n], 0, 0, 0); __builtin_amdgcn_s_setprio(0); } while (0)
#define PG8_WAIT_V(n) asm volatile("s_waitcnt vmcnt(" #n ")" ::: "memory")
#define PG8_WAIT_L(n) asm volatile("s_waitcnt lgkmcnt(" #n ")" ::: "memory")
#define PG8_BAR __builtin_amdgcn_s_barrier()
#define PG8_SCHED __builtin_amdgcn_sched_barrier(0)
    Unit cur, nxt; int ui = 0;
    if (!S.next(0, cur)) return;
    f32x4 acc[2][2][4][2];
#pragma unroll
    for (int a = 0; a < 2; ++a)
#pragma unroll
        for (int b = 0; b < 2; ++b)
#pragma unroll
            for (int m = 0; m < 4; ++m)
#pragma unroll
                for (int n = 0; n < 2; ++n) acc[a][b][m][n] = (f32x4){0.f, 0.f, 0.f, 0.f};
    bf16x8 At[4][2], B0[2][2], B1[2][2];
    const char* cA = (const char*)g.A + (size_t)cur.pm * tstep; const char* cB = (const char*)g.Bt + (size_t)cur.pn * tstep;
    S.a_ready(cur);
    PG8_STAGE(PG8_SB(0, 0), cB, voffB); PG8_STAGE(PG8_SA(0, 0), cA, voffA); PG8_STAGE(PG8_SB(0, 1), cB + hstep, voffB); PG8_STAGE(PG8_SA(0, 1), cA + hstep, voffA);
    if (wr == 1) PG8_BAR;
    PG8_WAIT_V(4); PG8_BAR;
    PG8_STAGE(PG8_SB(1, 0), cB + kstep, voffB); PG8_STAGE(PG8_SA(1, 0), cA + kstep, voffA); PG8_STAGE(PG8_SB(1, 1), cB + hstep + kstep, voffB);
    PG8_WAIT_V(6); PG8_BAR;
    PG8_STAMP();
    for (;;) {
        const bool has_next = S.next(ui + 1, nxt);
        const char* nA = has_next ? (const char*)g.A + (size_t)nxt.pm * tstep : cA; const char* nB = has_next ? (const char*)g.Bt + (size_t)nxt.pn * tstep : cB;
        for (int t = 0; t < nt; t += 2) {
            const bool last = (t == nt - 2);
            const char* a1 = cA + (size_t)(t + 1) * kstep;
            const char* a2 = last ? nA : cA + (size_t)(t + 2) * kstep; const char* b2 = last ? nB : cB + (size_t)(t + 2) * kstep;
            const char* a3 = a2 + kstep; const char* b3 = b2 + kstep;
            if (last && has_next) S.a_ready(nxt);
            PG8_LDB(B0, 0, 0); PG8_SCHED; PG8_LDA(At, 0, 0); PG8_STAGE(PG8_SA(1, 1), a1 + hstep, voffA);
            PG8_WAIT_L(8); PG8_BAR; PG8_WAIT_L(0); PG8_MMA(0, 0, At, B0); PG8_BAR; PG8_SCHED;
            PG8_LDB(B1, 0, 1); PG8_STAGE(PG8_SB(0, 0), b2, voffB);
            PG8_BAR; PG8_WAIT_L(0); PG8_MMA(0, 1, At, B1); PG8_BAR;
            PG8_LDA(At, 0, 1); PG8_STAGE(PG8_SA(0, 0), a2, voffA);
            PG8_BAR; PG8_WAIT_L(0); PG8_MMA(1, 0, At, B0); PG8_BAR; PG8_SCHED;
            PG8_STAGE(PG8_SB(0, 1), b2 + hstep, voffB);
            PG8_WAIT_V(6); PG8_BAR; PG8_MMA(1, 1, At, B1); PG8_BAR;
            PG8_LDB(B0, 1, 0); PG8_SCHED; PG8_LDA(At, 1, 0); PG8_STAGE(PG8_SA(0, 1), a2 + hstep, voffA);
            PG8_WAIT_L(8); PG8_BAR; PG8_WAIT_L(0); PG8_MMA(0, 0, At, B0); PG8_BAR; PG8_SCHED;
            PG8_LDB(B1, 1, 1); PG8_STAGE(PG8_SB(1, 0), b3, voffB);
            PG8_BAR; PG8_WAIT_L(0); PG8_MMA(0, 1, At, B1); PG8_BAR;
            PG8_LDA(At, 1, 1); PG8_STAGE(PG8_SA(1, 0), a3, voffA);
            PG8_BAR; PG8_WAIT_L(0); PG8_MMA(1, 0, At, B0); PG8_BAR; PG8_SCHED;
            PG8_STAGE(PG8_SB(1, 1), b3 + hstep, voffB);
            PG8_WAIT_V(6); PG8_BAR; PG8_MMA(1, 1, At, B1); PG8_BAR;
        }
        PG8_STAMP();
        if constexpr (!Epi::AFTER_DRAIN) { E(acc, cur, wr, wc, fr, fq); S.done(cur); }
        PG8_STAMP();
        if (!has_next) break;
#pragma unroll
        for (int a = 0; a < 2; ++a)
#pragma unroll
            for (int b = 0; b < 2; ++b)
#pragma unroll
                for (int m = 0; m < 4; ++m)
#pragma unroll
                    for (int n = 0; n < 2; ++n) acc[a][b][m][n] = (f32x4){0.f, 0.f, 0.f, 0.f};
        cur = nxt; cA = nA; cB = nB; ++ui;
    }
    PG8_WAIT_V(0);
    if (wr == 0) PG8_BAR;
    PG8_BAR;
    if constexpr (Epi::AFTER_DRAIN) { E.fused(acc, cur, wr, wc, fr, fq, lds, wid, lane); S.done(cur); }
    PG8_STAMP();
    if (STAMP && wid == 0) { stamps[lane] = lane < nts ? (((unsigned long long)(unsigned)ts_hi << 32) | (unsigned)ts_lo) : 0ull;
        if (lane == 62) stamps[62] = rt_entry; if (lane == 63) stamps[63] = (unsigned long long)wall_clock64(); }
#undef PG8_STAMP
#undef PG8_SA
#undef PG8_SB
#undef PG8_STAGE
#undef PG8_LDA
#undef PG8_LDB
#undef PG8_MMA
#undef PG8_WAIT_V
#undef PG8_WAIT_L
#undef PG8_BAR
#undef PG8_SCHED
}
}

#define LAS __attribute__((address_space(3)))
using pg8::bf16_t; using pg8::bf16x8; using pg8::f32x4; using pg8::u32x4;
typedef unsigned u32x2 __attribute__((ext_vector_type(2)));
typedef short s16x4 __attribute__((ext_vector_type(4)));

constexpr int T_ALL = 17408, T_P = 16384, DM = 1024, NPROJ = 4096, NIN = 4104, NUP = 5632, DFF = 2816;
constexpr int LDS_BYTES = 131072 + 4096;
constexpr int MISC_OFF = 131072;
constexpr size_t MiB = (size_t)1 << 20;
constexpr size_t al256(size_t x) { return (x + 255) & ~(size_t)255; }
constexpr size_t WS_WIN = 0, WS_WOUT = 8 * MiB, WS_WUP = 10 * MiB, WS_WDOWN = 21 * MiB;
constexpr size_t WS_GATES = 27 * MiB;
constexpr size_t WS_RC = al256(WS_GATES + (size_t)T_ALL * 8 * 4);
constexpr size_t WS_RS = al256(WS_RC + (size_t)2056 * 64 * 4);
constexpr size_t WS_GA = al256(WS_RS + (size_t)2056 * 64 * 4);
constexpr size_t WS_GCM = al256(WS_GA + (size_t)T_ALL * 4 * 4);
constexpr size_t WS_GB = al256(WS_GCM + (size_t)T_ALL * 4 * 4);
constexpr size_t WS_CHK = al256(WS_GB + (size_t)T_ALL * 4 * 4);
constexpr size_t WS_BAR = al256(WS_CHK + 1024 * 2 * 4);
constexpr size_t WS_SMALL_END = al256(WS_BAR + 3456 * 4);
static_assert(WS_SMALL_END <= 30 * MiB, "small region overflow");
constexpr size_t WS_X1 = 30 * MiB;
constexpr size_t WS_H = WS_X1, WS_LST = WS_X1 + 34 * MiB, WS_MIXIN = WS_X1;
constexpr size_t WS_PROJ = 98 * MiB;
constexpr size_t WS_MIXO = 98 * MiB;
constexpr size_t WS_FFN = 64 * MiB;
constexpr size_t WS_ACT = 98 * MiB;
constexpr size_t WS_EDGE = 192 * MiB, WS_HEAD = 204 * MiB;
constexpr size_t WS_H2 = 222 * MiB;
constexpr int LST_TILE = 136 * 128;
constexpr size_t O_Y = 0, O_SP = 17825792, O_SS = 18350080, O_CP = 26738688, O_CS = 27262976, O_NP = 35651584, O_NS = 35655680, O_MP = 35721216, O_MS = 35721248, O_BP = 35721760, O_BS = 35811872;

struct Args { const float* in[20]; float* out; unsigned char* ws; };

__device__ __forceinline__ float bf2f(unsigned short b) { return __uint_as_float(((unsigned)b) << 16); }
__device__ __forceinline__ unsigned pk2(float lo, float hi) { return pg8::cvt_pk_bf16(lo, hi); }
__device__ __forceinline__ float wave_sum(float v) {
#pragma unroll
    for (int o = 32; o >= 1; o >>= 1) v += __shfl_xor(v, o);
    return v; }
__device__ __forceinline__ const float* xrow(const Args& A, int r) { return r < T_P ? A.in[0] + (size_t)r * DM : A.in[1] + (size_t)(r - T_P) * DM; }
__device__ __forceinline__ float sigmoidf_(float x) { return 1.0f / (1.0f + __expf(-x)); }

__device__ __forceinline__ unsigned off_b(unsigned row, unsigned ch) { return 256u * row + 16u * (ch ^ (((row & 3) << 2) | ((row >> 2) & 3))); }
__device__ __forceinline__ unsigned rr_base(int lane) { return off_b(lane & 15, lane >> 4); }
__device__ __forceinline__ bf16x8 row_read(LAS unsigned char* tile, unsigned rr0, int rb, int s) { return *(const LAS bf16x8*)(tile + ((rr0 ^ (unsigned)(s << 6)) + 4096u * (unsigned)rb)); }
__device__ __forceinline__ unsigned tr_base_std(int lane, int t) { const unsigned g = lane >> 4, q = (lane & 15) >> 2, p = lane & 3; return 256u * (8 * g + 4 * t + q) + 16u * ((p >> 1) ^ ((q << 2) | ((2 * g + t) & 3))) + 8u * (p & 1); }
__device__ __forceinline__ unsigned tr_base_perm(int lane) { const unsigned g = lane >> 4, q = (lane & 15) >> 2, p = lane & 3; return 256u * (4 * g + q) + 16u * ((p >> 1) ^ ((q << 2) | g)) + 8u * (p & 1); }
__device__ __forceinline__ bf16x8 tr_frag(unsigned a0, unsigned a1) {
    s16x4 r0, r1;
    asm volatile("ds_read_b64_tr_b16 %0, %2\n\tds_read_b64_tr_b16 %1, %3\n\ts_waitcnt lgkmcnt(0)" : "=&v"(r0), "=&v"(r1) : "v"(a0), "v"(a1) : "memory");
    return __builtin_shufflevector(r0, r1, 0, 1, 2, 3, 4, 5, 6, 7); }
__device__ __forceinline__ void tr_frag2(unsigned a0, unsigned a1, unsigned a2, unsigned a3, bf16x8& f0, bf16x8& f1) {
    s16x4 r0, r1, r2, r3;
    asm volatile("ds_read_b64_tr_b16 %0, %4\n\tds_read_b64_tr_b16 %1, %5\n\tds_read_b64_tr_b16 %2, %6\n\tds_read_b64_tr_b16 %3, %7\n\ts_waitcnt lgkmcnt(0)"
                 : "=&v"(r0), "=&v"(r1), "=&v"(r2), "=&v"(r3) : "v"(a0), "v"(a1), "v"(a2), "v"(a3) : "memory");
    f0 = __builtin_shufflevector(r0, r1, 0, 1, 2, 3, 4, 5, 6, 7); f1 = __builtin_shufflevector(r2, r3, 0, 1, 2, 3, 4, 5, 6, 7); }
#define OPAQUE(x) asm volatile("" : "+v"(x))
#define MFMA16(a, b, c) __builtin_amdgcn_mfma_f32_16x16x32_bf16((a), (b), (c), 0, 0, 0)

template <bool ROT>
__device__ __forceinline__ void fill_bf16(LAS unsigned char* tile, const bf16_t* src, int ld, int nvalid, int ntotal, int pos0, const float* RC, const float* RS, float scale, const LAS float* wrow) {
    for (int idx = threadIdx.x; idx < ntotal * 8; idx += 512) {
        const int row = idx >> 3, ch = idx & 7;
        u32x4 lo = {0u, 0u, 0u, 0u}, hi = {0u, 0u, 0u, 0u};
        if (row < nvalid) {
            const bf16_t* p = src + (size_t)row * ld + ch * 8; lo = *(const u32x4*)p; hi = *(const u32x4*)(p + 64);
            if (ROT || scale != 1.0f || wrow != nullptr) {
                float a[8], b[8];
#pragma unroll
                for (int j = 0; j < 4; ++j) { a[2 * j] = __uint_as_float(lo[j] << 16); a[2 * j + 1] = __uint_as_float(lo[j] & 0xffff0000u); b[2 * j] = __uint_as_float(hi[j] << 16); b[2 * j + 1] = __uint_as_float(hi[j] & 0xffff0000u); }
                if (ROT) {
                    const float* cp = RC + (size_t)(pos0 + row) * 64 + ch * 8; const float* sp = RS + (size_t)(pos0 + row) * 64 + ch * 8;
                    const f32x4 c0 = *(const f32x4*)cp, c1 = *(const f32x4*)(cp + 4), s0 = *(const f32x4*)sp, s1 = *(const f32x4*)(sp + 4);
#pragma unroll
                    for (int j = 0; j < 8; ++j) { const float cc = j < 4 ? c0[j & 3] : c1[j & 3], ss = j < 4 ? s0[j & 3] : s1[j & 3]; const float x1 = a[j], x2 = b[j]; a[j] = x1 * cc - x2 * ss; b[j] = x1 * ss + x2 * cc; }
                }
                const float m = scale * (wrow != nullptr ? wrow[row] : 1.0f);
#pragma unroll
                for (int j = 0; j < 4; ++j) { lo[j] = pk2(a[2 * j] * m, a[2 * j + 1] * m); hi[j] = pk2(b[2 * j] * m, b[2 * j + 1] * m); }
            }
        }
        *(LAS u32x4*)(tile + off_b(row, ch)) = lo; *(LAS u32x4*)(tile + off_b(row, ch + 8)) = hi;
    }
}
__device__ __forceinline__ void fill_from_f32(LAS unsigned char* tile, const float* src) {
    for (int idx = threadIdx.x; idx < 2048; idx += 512) { const int row = idx >> 4, ch = idx & 15; const float* p = src + row * 128 + ch * 8;
        const f32x4 a = *(const f32x4*)p, b = *(const f32x4*)(p + 4); u32x4 w; w[0] = pk2(a[0], a[1]); w[1] = pk2(a[2], a[3]); w[2] = pk2(b[0], b[1]); w[3] = pk2(b[2], b[3]);
        *(LAS u32x4*)(tile + off_b(row, ch)) = w; }
}
__device__ __forceinline__ void fill_copy(LAS unsigned char* tile, const bf16_t* src) {
    for (int idx = threadIdx.x; idx < 2048; idx += 512) { const int row = idx >> 4, ch = idx & 15; *(LAS u32x4*)(tile + off_b(row, ch)) = *(const u32x4*)(src + row * 128 + ch * 8); }
}

template <int NKS, bool NROW>
__device__ __forceinline__ void local_prod(f32x4 (&acc)[9], unsigned kimg, unsigned vimg, const LAS float* wrow, int w, int lane) {
    const int g = lane >> 4, i = lane & 15;
    const unsigned tb0 = tr_base_std(lane, 0), tb1 = tr_base_std(lane, 1);
#pragma unroll
    for (int ks = 0; ks < NKS; ++ks) {
        unsigned b0_ = tb0, b1_ = tb1; OPAQUE(b0_); OPAQUE(b1_);
        const unsigned ko = kimg + 8192u * ks, vo = vimg + 8192u * ks;
        const bf16x8 a = tr_frag((b0_ ^ ((unsigned)w << 5)) + ko, (b1_ ^ ((unsigned)w << 5)) + ko);
#pragma unroll
        for (int c = 0; c < 8; c += 2) { bf16x8 f0, f1; tr_frag2((b0_ ^ (unsigned)(c << 5)) + vo, (b1_ ^ (unsigned)(c << 5)) + vo, (b0_ ^ (unsigned)((c + 1) << 5)) + vo, (b1_ ^ (unsigned)((c + 1) << 5)) + vo, f0, f1);
            acc[c] = MFMA16(a, f0, acc[c]); acc[c + 1] = MFMA16(a, f1, acc[c + 1]); }
        if (NROW) {
            const int rb0 = 32 * ks + 8 * g;
            const f32x4 w0 = *(const LAS f32x4*)(wrow + rb0), w1 = *(const LAS f32x4*)(wrow + rb0 + 4);
            u32x4 bw; bw[0] = pk2(w0[0], w0[1]); bw[1] = pk2(w0[2], w0[3]); bw[2] = pk2(w1[0], w1[1]); bw[3] = pk2(w1[2], w1[3]);
            if (i != 0) bw = (u32x4){0u, 0u, 0u, 0u};
            acc[8] = MFMA16(a, __builtin_bit_cast(bf16x8, bw), acc[8]);
        }
    }
}

template <int GRP, bool GTR>
__device__ __forceinline__ void out_wave(const Args& A, LAS unsigned char* qimg, LAS unsigned char* kimg, LAS unsigned char* vimg, LAS unsigned char* gimg, const LAS float* misc,
                                         float m_prev, float lg2g, int w, int lane, int t0, int nvalid, int h) {
    const int i = lane & 15, g = lane >> 4;
    const unsigned vbase = (unsigned)(size_t)vimg, gbase = (unsigned)(size_t)gimg;
    const LAS float* a_s = misc + 128; const LAS float* cmx = misc + 256; const LAS float* bbs = misc + 384; const LAS unsigned char* nl = (const LAS unsigned char*)(misc + 512);
    const unsigned rr0 = rr_base(lane);
    bf16x8 qf[4];
#pragma unroll
    for (int kd = 0; kd < 4; ++kd) qf[kd] = row_read(qimg, rr0, w, kd);
    f32x4 pT[8];
#pragma unroll
    for (int c = 0; c < 8; ++c) pT[c] = (f32x4){0.f, 0.f, 0.f, 0.f};
#pragma unroll
    for (int c = 0; c < 8; ++c) if (c <= w) {
#pragma unroll
        for (int kd = 0; kd < 4; ++kd) pT[c] = MFMA16(row_read(kimg, rr0, c, kd), qf[kd], pT[c]);
    }
    const int t = 16 * w + i;
    const float Mt_i = GRP ? fmaxf(m_prev, cmx[t]) : 0.f;
#pragma unroll
    for (int c = 0; c < 8; ++c) if (c <= w) {
        f32x4 av = (f32x4){0.f, 0.f, 0.f, 0.f}; if (GRP) av = *(const LAS f32x4*)(a_s + 16 * c + 4 * g);
#pragma unroll
        for (int r = 0; r < 4; ++r) { const int s = 16 * c + 4 * g + r; float wg;
            if (GRP) wg = __expf(av[r] - Mt_i); else wg = exp2f((float)(t - s) * lg2g);
            pT[c][r] = (s <= t) ? pT[c][r] * wg : 0.f; }
    }
    f32x4 acc[9];
#pragma unroll
    for (int c = 0; c < 9; ++c) acc[c] = (f32x4){0.f, 0.f, 0.f, 0.f};
#pragma unroll
    for (int kd = 0; kd < 4; ++kd) {
#pragma unroll
        for (int cv = 0; cv < 8; cv += 2) {
            bf16x8 b0, b1;
            if (GTR) { unsigned x0 = tr_base_std(lane, 0), x1 = tr_base_std(lane, 1); OPAQUE(x0); OPAQUE(x1); const unsigned go = gbase + 8192u * kd;
                tr_frag2((x0 ^ (unsigned)(cv << 5)) + go, (x1 ^ (unsigned)(cv << 5)) + go, (x0 ^ (unsigned)((cv + 1) << 5)) + go, (x1 ^ (unsigned)((cv + 1) << 5)) + go, b0, b1); }
            else { b0 = row_read(gimg, rr0, cv, kd); b1 = row_read(gimg, rr0, cv + 1, kd); }
            acc[cv] = MFMA16(qf[kd], b0, acc[cv]); acc[cv + 1] = MFMA16(qf[kd], b1, acc[cv + 1]);
        }
        if (GRP) { u32x4 bn = *(const LAS u32x4*)(nl + (32 * kd + 8 * g) * 2); if (i != 0) bn = (u32x4){0u, 0u, 0u, 0u}; acc[8] = MFMA16(qf[kd], __builtin_bit_cast(bf16x8, bn), acc[8]); }
    }
    float Mt_r[4];
#pragma unroll
    for (int r = 0; r < 4; ++r) { const int tl = 16 * w + 4 * g + r; float sc;
        if (GRP) { Mt_r[r] = fmaxf(m_prev, cmx[tl]); sc = __expf(m_prev - Mt_r[r]); } else { Mt_r[r] = 0.f; sc = exp2f((float)(tl + 1) * lg2g); }
#pragma unroll
        for (int c = 0; c < 9; ++c) acc[c][r] *= sc; }
    u32x4 ones = (u32x4){0x3f803f80u, 0x3f803f80u, 0x3f803f80u, 0x3f803f80u}; if (i != 0) ones = (u32x4){0u, 0u, 0u, 0u};
#pragma unroll
    for (int ks = 0; ks < 4; ++ks) if (2 * ks <= w) {
        u32x4 pa; pa[0] = pk2(pT[2 * ks][0], pT[2 * ks][1]); pa[1] = pk2(pT[2 * ks][2], pT[2 * ks][3]); pa[2] = pk2(pT[2 * ks + 1][0], pT[2 * ks + 1][1]); pa[3] = pk2(pT[2 * ks + 1][2], pT[2 * ks + 1][3]);
        const bf16x8 af = __builtin_bit_cast(bf16x8, pa);
        unsigned tp = tr_base_perm(lane); OPAQUE(tp); const unsigned vo = vbase + 8192u * ks;
#pragma unroll
        for (int cv = 0; cv < 8; cv += 2) { bf16x8 b0, b1; const unsigned y0 = (tp ^ (unsigned)(cv << 5)) + vo, y1 = (tp ^ (unsigned)((cv + 1) << 5)) + vo;
            tr_frag2(y0, y0 + 4096u, y1, y1 + 4096u, b0, b1); acc[cv] = MFMA16(af, b0, acc[cv]); acc[cv + 1] = MFMA16(af, b1, acc[cv + 1]); }
        if (GRP) acc[8] = MFMA16(af, __builtin_bit_cast(bf16x8, ones), acc[8]);
    }
    const float* gain = (GRP ? A.in[11] : A.in[10]) + h * 128;
    const bf16_t* PROJ = (const bf16_t*)(A.ws + WS_PROJ); bf16_t* MIXIN = (bf16_t*)(A.ws + WS_MIXIN);
    const int gcol = (GRP ? 3584 : 1536) + h * 128;
    float gn[8];
#pragma unroll
    for (int cv = 0; cv < 8; ++cv) gn[cv] = gain[16 * cv + i];
#pragma unroll
    for (int r = 0; r < 4; ++r) {
        const int tl = 16 * w + 4 * g + r;
        float hv[8];
        float inv = 1.0f;
        if (GRP) { const float dd = __shfl(acc[8][r], lane & 48); const float mt = bbs[tl] + Mt_r[r]; inv = 1.0f / fmaxf(fabsf(dd), __expf(-mt)); }
        float s1 = 0.f;
#pragma unroll
        for (int cv = 0; cv < 8; ++cv) { hv[cv] = acc[cv][r] * inv; s1 += hv[cv]; }
        s1 += __shfl_xor(s1, 1); s1 += __shfl_xor(s1, 2); s1 += __shfl_xor(s1, 4); s1 += __shfl_xor(s1, 8);
        const float mu = s1 * (1.0f / 128.0f); float s2 = 0.f;
#pragma unroll
        for (int cv = 0; cv < 8; ++cv) { const float d = hv[cv] - mu; s2 += d * d; }
        s2 += __shfl_xor(s2, 1); s2 += __shfl_xor(s2, 2); s2 += __shfl_xor(s2, 4); s2 += __shfl_xor(s2, 8);
        const float rstd = rsqrtf(s2 * (1.0f / 128.0f) + 1e-6f);
        if (tl < nvalid) {
            const bf16_t* gp = PROJ + (size_t)(t0 + tl) * NPROJ + gcol + i; bf16_t* op = MIXIN + (size_t)(t0 + tl) * DM + GRP * 512 + h * 128 + i;
#pragma unroll
            for (int cv = 0; cv < 8; ++cv) { const float gv = bf2f(gp[16 * cv]); const float sg = sigmoidf_(gv); const float act = GRP ? sg : gv * sg;
                const float y = (hv[cv] - mu) * rstd * gn[cv] * act; op[16 * cv] = (bf16_t)(pk2(y, y) & 0xffffu); }
        }
    }
}

__device__ void phase_convert_weights(const Args& A, LAS unsigned char* lds) {
    LAS float* tile = (LAS float*)lds;
    const int tid = threadIdx.x;
    constexpr int NT_IN = 64 * 16, NT_OUT = 16 * 16, NT_UP = 88 * 16, NT_DOWN = 16 * 44;
    for (int t = blockIdx.x; t < NT_IN + NT_OUT + NT_UP + NT_DOWN; t += gridDim.x) {
        const float* W; bf16_t* Bt; int K, ld, which, tt = t;
        if (tt < NT_IN) { which = 0; W = A.in[8]; ld = NIN; K = 1024; Bt = (bf16_t*)(A.ws + WS_WIN); }
        else if ((tt -= NT_IN) < NT_OUT) { which = 1; W = A.in[12]; ld = 1024; K = 1024; Bt = (bf16_t*)(A.ws + WS_WOUT); }
        else if ((tt -= NT_OUT) < NT_UP) { which = 2; W = A.in[15]; ld = NUP; K = 1024; Bt = (bf16_t*)(A.ws + WS_WUP); }
        else { tt -= NT_UP; which = 3; W = A.in[18]; ld = 1024; K = 2816; Bt = (bf16_t*)(A.ws + WS_WDOWN); }
        const int ktiles = K / 64, nt = tt / ktiles, kt = tt % ktiles, n0 = nt * 64, k0 = kt * 64;
        int c0 = n0; if (which == 2) { const int pn = n0 >> 8, bj = (n0 >> 7) & 1, ii = n0 & 127; c0 = bj * DFF + 128 * pn + ii; }
        { const int k = tid >> 3, n8 = (tid & 7) * 8; const float* p = W + (size_t)(k0 + k) * ld + c0 + n8;
          const f32x4 a = *(const f32x4*)p, b = *(const f32x4*)(p + 4); LAS float* d = tile + k * 65 + n8;
          d[0] = a[0]; d[1] = a[1]; d[2] = a[2]; d[3] = a[3]; d[4] = b[0]; d[5] = b[1]; d[6] = b[2]; d[7] = b[3]; }
        __syncthreads();
        { const int n = tid >> 3, k8 = (tid & 7) * 8; float v[8];
#pragma unroll
          for (int j = 0; j < 8; ++j) v[j] = tile[(k8 + j) * 65 + n];
          u32x4 w; w[0] = pk2(v[0], v[1]); w[1] = pk2(v[2], v[3]); w[2] = pk2(v[4], v[5]); w[3] = pk2(v[6], v[7]);
          *(u32x4*)(Bt + (size_t)(n0 + n) * K + k0 + k8) = w; }
        __syncthreads();
    }
}

__device__ void phase_prep_rows(const Args& A) {
    const int lane = threadIdx.x & 63, wid = threadIdx.x >> 6;
    bf16_t* H = (bf16_t*)(A.ws + WS_H); float* GATES = (float*)(A.ws + WS_GATES);
    for (int r = blockIdx.x * 8 + wid; r < T_ALL; r += gridDim.x * 8) {
        const float* x = xrow(A, r); f32x4 v[4]; float ss = 0.f;
#pragma unroll
        for (int q = 0; q < 4; ++q) { v[q] = *(const f32x4*)(x + q * 256 + lane * 4); ss += v[q][0] * v[q][0] + v[q][1] * v[q][1] + v[q][2] * v[q][2] + v[q][3] * v[q][3]; }
        ss = wave_sum(ss); const float rstd = rsqrtf(ss * (1.0f / 1024.0f) + 1e-6f);
        float g8[8];
#pragma unroll
        for (int j = 0; j < 8; ++j) g8[j] = 0.f;
#pragma unroll
        for (int q = 0; q < 4; ++q) {
            const f32x4 gn = *(const f32x4*)(A.in[7] + q * 256 + lane * 4); const f32x4 hh = v[q] * rstd * gn;
            u32x2 w; w[0] = pk2(hh[0], hh[1]); w[1] = pk2(hh[2], hh[3]); *(u32x2*)(H + (size_t)r * DM + q * 256 + lane * 4) = w;
#pragma unroll
            for (int e = 0; e < 4; ++e) { const float* wg = A.in[8] + (size_t)(q * 256 + lane * 4 + e) * NIN + 4096; const f32x4 w0 = *(const f32x4*)wg, w1 = *(const f32x4*)(wg + 4);
#pragma unroll
                for (int j = 0; j < 4; ++j) { g8[j] += hh[e] * w0[j]; g8[4 + j] += hh[e] * w1[j]; } }
        }
        float outv = 0.f;
#pragma unroll
        for (int j = 0; j < 8; ++j) { const float s = wave_sum(g8[j]); if (lane == j) outv = s; }
        if (lane < 8) GATES[(size_t)r * 8 + lane] = outv + A.in[9][lane];
    }
}

__device__ void phase_rope_table(const Args& A) {
    float* RC = (float*)(A.ws + WS_RC); float* RS = (float*)(A.ws + WS_RS);
    for (int idx = blockIdx.x * 512 + threadIdx.x; idx < 2056 * 64; idx += gridDim.x * 512) {
        const int p = idx >> 6, i = idx & 63; const double pos = p < 2048 ? (double)p : (double)(16384 + (p - 2048));
        const double freq = exp2(-(double)i * (13.287712379549449 / 64.0)); double rev = pos * freq * 0.15915494309189535; rev -= rint(rev);
        const float fr = (float)rev; RC[idx] = __builtin_amdgcn_cosf(fr); RS[idx] = __builtin_amdgcn_sinf(fr);
    }
}

__device__ __forceinline__ float logsig(float f) { return f > 0.f ? -log1pf(__expf(-f)) : f - log1pf(__expf(f)); }
__device__ void phase_gate_scan(const Args& A) {
    const int lane = threadIdx.x & 63, wid = threadIdx.x >> 6;
    const float* GATES = (const float*)(A.ws + WS_GATES); float* GA = (float*)(A.ws + WS_GA); float* GCM = (float*)(A.ws + WS_GCM); float* GB = (float*)(A.ws + WS_GB); float* CHK = (float*)(A.ws + WS_CHK);
    for (int u = blockIdx.x * 8 + wid; u < 1024; u += gridDim.x * 8) {
        int t0, len, h;
        if (u < 512) { const int b = u >> 6, c = u & 15; h = (u >> 4) & 3; t0 = b * 2048 + c * 128; len = 128; } else { const int v = u - 512, b = v >> 2; h = v & 3; t0 = T_P + b * 8; len = 8; }
        const int s0 = 2 * lane, s1 = s0 + 1; const bool v0 = s0 < len, v1 = s1 < len;
        float i0 = 0.f, i1 = 0.f, l0 = 0.f, l1 = 0.f;
        if (v0) { i0 = GATES[(size_t)(t0 + s0) * 8 + h]; l0 = logsig(GATES[(size_t)(t0 + s0) * 8 + 4 + h]); }
        if (v1) { i1 = GATES[(size_t)(t0 + s1) * 8 + h]; l1 = logsig(GATES[(size_t)(t0 + s1) * 8 + 4 + h]); }
        float x = l0 + l1;
#pragma unroll
        for (int o = 1; o < 64; o <<= 1) { const float y = __shfl_up(x, o); if (lane >= o) x += y; }
        const float ex = x - (l0 + l1), b0 = ex + l0, b1 = b0 + l1;
        const float a0 = v0 ? i0 - b0 : -3e38f, a1 = v1 ? i1 - b1 : -3e38f;
        float mx = fmaxf(a0, a1);
#pragma unroll
        for (int o = 1; o < 64; o <<= 1) { const float y = __shfl_up(mx, o); if (lane >= o) mx = fmaxf(mx, y); }
        float pm = __shfl_up(mx, 1); if (lane == 0) pm = -3e38f;
        const float c0 = fmaxf(pm, a0), c1 = fmaxf(c0, a1);
        if (v0) { const size_t o = (size_t)(t0 + s0) * 4 + h; GB[o] = b0; GA[o] = a0; GCM[o] = c0; }
        if (v1) { const size_t o = (size_t)(t0 + s1) * 4 + h; GB[o] = b1; GA[o] = a1; GCM[o] = c1; }
        const float Btot = __shfl(x, 63), Amax = __shfl(mx, 63);
        if (lane == 0) { CHK[u * 2] = Btot; CHK[u * 2 + 1] = Amax; }
    }
}

__device__ void local_unit(const Args& A, LAS unsigned char* lds, int seq, int c) {
    int tid_ = threadIdx.x; OPAQUE(tid_); const int tid = tid_, lane = tid & 63, w = __builtin_amdgcn_readfirstlane(tid >> 6), g = lane >> 4, i = lane & 15;
    const int grp = seq >> 5, b = (seq >> 2) & 7, h = seq & 3, t0 = b * 2048 + c * 128;
    LAS float* misc = (LAS float*)(lds + MISC_OFF);
    const float lg2g = log2f(1.0f - exp2f(-5.0f - (float)h));
    const float* GA = (const float*)(A.ws + WS_GA); const float* CHK = (const float*)(A.ws + WS_CHK);
    if (tid < 128) { float wv; if (grp == 0) wv = exp2f((float)(127 - tid) * lg2g); else { const float Amax = CHK[((seq & 31) * 16 + c) * 2 + 1]; wv = __expf(GA[(size_t)(t0 + tid) * 4 + h] - Amax); } misc[tid] = wv; }
    __syncthreads();
    const bf16_t* PROJ = (const bf16_t*)(A.ws + WS_PROJ) + (size_t)t0 * NPROJ;
    const float* RC = (const float*)(A.ws + WS_RC); const float* RS = (const float*)(A.ws + WS_RS);
    LAS unsigned char* T0 = lds; LAS unsigned char* T1 = lds + 32768;
    const float kscale = 0.08838834764831845f;
    if (grp == 0) fill_bf16<true>(T0, PROJ + 512 + h * 128, NPROJ, 128, 128, c * 128, RC, RS, kscale, nullptr);
    else fill_bf16<false>(T0, PROJ + 2560 + h * 128, NPROJ, 128, 128, 0, RC, RS, kscale, nullptr);
    fill_bf16<false>(T1, PROJ + (grp ? 3072 : 1024) + h * 128, NPROJ, 128, 128, 0, RC, RS, 1.0f, misc);
    __syncthreads();
    f32x4 acc[9];
#pragma unroll
    for (int q = 0; q < 9; ++q) acc[q] = (f32x4){0.f, 0.f, 0.f, 0.f};
    if (grp) local_prod<4, true>(acc, (unsigned)(size_t)T0, (unsigned)(size_t)T1, misc, w, lane); else local_prod<4, false>(acc, (unsigned)(size_t)T0, (unsigned)(size_t)T1, misc, w, lane);
    bf16_t* L = (bf16_t*)(A.ws + WS_LST) + (size_t)(seq * 16 + c) * LST_TILE;
#pragma unroll
    for (int cc = 0; cc < 8; ++cc) { u32x2 o; o[0] = pk2(acc[cc][0], acc[cc][1]); o[1] = pk2(acc[cc][2], acc[cc][3]); *(u32x2*)(L + (16 * cc + i) * 128 + 16 * w + 4 * g) = o; }
    if (grp && i == 0) { u32x2 o; o[0] = pk2(acc[8][0], acc[8][1]); o[1] = pk2(acc[8][2], acc[8][3]); *(u32x2*)(L + 128 * 128 + 16 * w + 4 * g) = o; }
    __syncthreads();
}

__device__ void sample_unit(const Args& A, LAS unsigned char* lds, int grp, int b, int h) {
    int tid_ = threadIdx.x; OPAQUE(tid_); const int tid = tid_, lane = tid & 63, w = __builtin_amdgcn_readfirstlane(tid >> 6), g = lane >> 4, i = lane & 15;
    const int t0 = T_P + b * 8, bh = b * 4 + h;
    LAS float* misc = (LAS float*)(lds + MISC_OFF);
    const float lg2g = log2f(1.0f - exp2f(-5.0f - (float)h));
    const float* GA = (const float*)(A.ws + WS_GA); const float* GCM = (const float*)(A.ws + WS_GCM); const float* GB = (const float*)(A.ws + WS_GB); const float* CHK = (const float*)(A.ws + WS_CHK);
    float m0 = 0.f, Btot = 0.f, Mlast = 0.f;
    if (grp) { m0 = A.in[5][bh]; Btot = CHK[(512 + bh) * 2]; Mlast = fmaxf(m0, CHK[(512 + bh) * 2 + 1]); }
    if (tid < 128) {
        float wv = 0.f, av = -3e38f, cv = 0.f, bv = 0.f;
        if (tid < 8) { if (grp) { const size_t o = (size_t)(t0 + tid) * 4 + h; av = GA[o]; cv = GCM[o]; bv = GB[o]; wv = __expf(av - Mlast); } else wv = exp2f((float)(7 - tid) * lg2g); }
        misc[tid] = wv; misc[128 + tid] = av; misc[256 + tid] = cv; misc[384 + tid] = bv;
        if (tid < 64) { unsigned nn = 0u; if (grp) nn = pk2(A.in[4][bh * 128 + 2 * tid], A.in[4][bh * 128 + 2 * tid + 1]); ((LAS unsigned*)(misc + 512))[tid] = nn; }
    }
    __syncthreads();
    const bf16_t* PROJ = (const bf16_t*)(A.ws + WS_PROJ) + (size_t)t0 * NPROJ;
    const float* RC = (const float*)(A.ws + WS_RC); const float* RS = (const float*)(A.ws + WS_RS);
    LAS unsigned char* TQ = lds; LAS unsigned char* TK = lds + 8192; LAS unsigned char* TV = lds + 16384; LAS unsigned char* TW = lds + 24576; LAS unsigned char* TG = lds + 32768;
    const float kscale = 0.08838834764831845f;
    const int qc = (grp ? 2048 : 0) + h * 128, kc = (grp ? 2560 : 512) + h * 128, vc = (grp ? 3072 : 1024) + h * 128;
    if (grp == 0) { fill_bf16<true>(TQ, PROJ + qc, NPROJ, 8, 32, 2048, RC, RS, 1.0f, nullptr); fill_bf16<true>(TK, PROJ + kc, NPROJ, 8, 32, 2048, RC, RS, kscale, nullptr); }
    else { fill_bf16<false>(TQ, PROJ + qc, NPROJ, 8, 32, 0, RC, RS, 1.0f, nullptr); fill_bf16<false>(TK, PROJ + kc, NPROJ, 8, 32, 0, RC, RS, kscale, nullptr); }
    fill_bf16<false>(TV, PROJ + vc, NPROJ, 8, 32, 0, RC, RS, 1.0f, nullptr);
    fill_bf16<false>(TW, PROJ + vc, NPROJ, 8, 32, 0, RC, RS, 1.0f, misc);
    const float* S0 = (grp ? A.in[3] : A.in[2]) + (size_t)bh * 16384;
    fill_from_f32(TG, S0);
    __syncthreads();
    if (w == 0) { if (grp) out_wave<1, false>(A, TQ, TK, TV, TG, misc, m0, lg2g, 0, lane, t0, 8, h); else out_wave<0, true>(A, TQ, TK, TV, TG, misc, 0.f, lg2g, 0, lane, t0, 8, h); }
    f32x4 acc[9];
#pragma unroll
    for (int q = 0; q < 9; ++q) acc[q] = (f32x4){0.f, 0.f, 0.f, 0.f};
    if (grp) local_prod<1, true>(acc, (unsigned)(size_t)TK, (unsigned)(size_t)TW, misc, w, lane); else local_prod<1, false>(acc, (unsigned)(size_t)TK, (unsigned)(size_t)TW, misc, w, lane);
    if (grp == 0) {
        const float dec = exp2f(8.0f * lg2g); float* So = A.out + O_SS + (size_t)bh * 16384;
#pragma unroll
        for (int cv = 0; cv < 8; ++cv)
#pragma unroll
            for (int r = 0; r < 4; ++r) { const int idx = (16 * w + 4 * g + r) * 128 + 16 * cv + i; So[idx] = dec * S0[idx] + acc[cv][r]; }
    } else {
        const float dec = __expf(m0 - Mlast); float* Co = A.out + O_CS + (size_t)bh * 16384;
#pragma unroll
        for (int cv = 0; cv < 8; ++cv) { const int idx = (16 * cv + i) * 128 + 16 * w + 4 * g; const f32x4 c0 = *(const f32x4*)(S0 + idx); *(f32x4*)(Co + idx) = c0 * dec + acc[cv]; }
        if (i == 0) { const int d = 16 * w + 4 * g; const f32x4 n0 = *(const f32x4*)(A.in[4] + bh * 128 + d); *(f32x4*)(A.out + O_NS + bh * 128 + d) = n0 * dec + acc[8]; }
        if (tid == 0) A.out[O_MS + bh] = Btot + Mlast;
    }
    __syncthreads();
}

__device__ void phase_local_and_sample(const Args& A, LAS unsigned char* lds) {
    for (int u = blockIdx.x; u < 2048; u += gridDim.x) {
        if (u < 1024) local_unit(A, lds, u >> 4, u & 15);
        else { const int v = u - 1024; sample_unit(A, lds, v >> 9, (v >> 2) & 127, v & 3); }
    }
}

__device__ void phase_scan(const Args& A) {
    bf16_t* LST = (bf16_t*)(A.ws + WS_LST); const float* CHK = (const float*)(A.ws + WS_CHK);
    for (int idx = blockIdx.x * 512 + threadIdx.x; idx < 64 * 4128; idx += gridDim.x * 512) {
        const int seq = idx / 4128, e = idx % 4128, row = e >> 5, d4 = (e & 31) * 4, grp = seq >> 5, b = (seq >> 2) & 7, h = seq & 3, bh = b * 4 + h;
        if (grp == 0 && row == 128) continue;
        bf16_t* base = LST + (size_t)seq * 16 * LST_TILE + row * 128 + d4;
        u32x2 Lv[16];
#pragma unroll
        for (int c = 0; c < 16; ++c) Lv[c] = *(const u32x2*)(base + (size_t)c * LST_TILE);
        float G0 = 0.f, G1 = 0.f, G2 = 0.f, G3 = 0.f, m = -1e30f;
        const float lg2g = log2f(1.0f - exp2f(-5.0f - (float)h)); const float rdec = exp2f(128.0f * lg2g);
#pragma unroll
        for (int c = 0; c < 16; ++c) {
            u32x2 o; o[0] = pk2(G0, G1); o[1] = pk2(G2, G3); *(u32x2*)(base + (size_t)c * LST_TILE) = o;
            float dec = rdec, fac = 1.0f;
            if (grp) { const float Bt = CHK[(bh * 16 + c) * 2], Am = CHK[(bh * 16 + c) * 2 + 1]; const float Ml = fmaxf(m, Am); dec = __expf(m - Ml); fac = __expf(Am - Ml); m = Bt + Ml; }
            const float l0 = __uint_as_float(Lv[c][0] << 16), l1 = __uint_as_float(Lv[c][0] & 0xffff0000u), l2 = __uint_as_float(Lv[c][1] << 16), l3 = __uint_as_float(Lv[c][1] & 0xffff0000u);
            G0 = dec * G0 + fac * l0; G1 = dec * G1 + fac * l1; G2 = dec * G2 + fac * l2; G3 = dec * G3 + fac * l3;
        }
        if (grp == 0) { float* So = A.out + O_SP + (size_t)bh * 16384; So[(d4 + 0) * 128 + row] = G0; So[(d4 + 1) * 128 + row] = G1; So[(d4 + 2) * 128 + row] = G2; So[(d4 + 3) * 128 + row] = G3; }
        else if (row < 128) *(f32x4*)(A.out + O_CP + (size_t)bh * 16384 + row * 128 + d4) = (f32x4){G0, G1, G2, G3};
        else { *(f32x4*)(A.out + O_NP + bh * 128 + d4) = (f32x4){G0, G1, G2, G3}; if (d4 == 0) A.out[O_MP + bh] = m; }
    }
}

__device__ void out_unit(const Args& A, LAS unsigned char* lds, int seq, int c) {
    int tid_ = threadIdx.x; OPAQUE(tid_); const int tid = tid_, lane = tid & 63, w = __builtin_amdgcn_readfirstlane(tid >> 6);
    const int grp = seq >> 5, b = (seq >> 2) & 7, h = seq & 3, t0 = b * 2048 + c * 128, bh = b * 4 + h;
    LAS float* misc = (LAS float*)(lds + MISC_OFF);
    const float lg2g = log2f(1.0f - exp2f(-5.0f - (float)h));
    const float* GA = (const float*)(A.ws + WS_GA); const float* GCM = (const float*)(A.ws + WS_GCM); const float* GB = (const float*)(A.ws + WS_GB); const float* CHK = (const float*)(A.ws + WS_CHK);
    const bf16_t* L = (const bf16_t*)(A.ws + WS_LST) + (size_t)(seq * 16 + c) * LST_TILE;
    float m_prev = -1e30f;
    if (grp) for (int cc = 0; cc < c; ++cc) m_prev = CHK[(bh * 16 + cc) * 2] + fmaxf(m_prev, CHK[(bh * 16 + cc) * 2 + 1]);
    if (tid < 128) {
        float av = 0.f, cv = 0.f, bv = 0.f;
        if (grp) { const size_t o = (size_t)(t0 + tid) * 4 + h; av = GA[o]; cv = GCM[o]; bv = GB[o]; }
        misc[128 + tid] = av; misc[256 + tid] = cv; misc[384 + tid] = bv;
        if (tid < 64) ((LAS unsigned*)(misc + 512))[tid] = grp ? ((const unsigned*)(L + 128 * 128))[tid] : 0u;
    }
    const bf16_t* PROJ = (const bf16_t*)(A.ws + WS_PROJ) + (size_t)t0 * NPROJ;
    const float* RC = (const float*)(A.ws + WS_RC); const float* RS = (const float*)(A.ws + WS_RS);
    LAS unsigned char* TQ = lds; LAS unsigned char* TK = lds + 32768; LAS unsigned char* TV = lds + 65536; LAS unsigned char* TG = lds + 98304;
    const float kscale = 0.08838834764831845f;
    const int qc = (grp ? 2048 : 0) + h * 128, kc = (grp ? 2560 : 512) + h * 128, vc = (grp ? 3072 : 1024) + h * 128;
    if (grp == 0) { fill_bf16<true>(TQ, PROJ + qc, NPROJ, 128, 128, c * 128, RC, RS, 1.0f, nullptr); fill_bf16<true>(TK, PROJ + kc, NPROJ, 128, 128, c * 128, RC, RS, kscale, nullptr); }
    else { fill_bf16<false>(TQ, PROJ + qc, NPROJ, 128, 128, 0, RC, RS, 1.0f, nullptr); fill_bf16<false>(TK, PROJ + kc, NPROJ, 128, 128, 0, RC, RS, kscale, nullptr); }
    fill_bf16<false>(TV, PROJ + vc, NPROJ, 128, 128, 0, RC, RS, 1.0f, nullptr);
    fill_copy(TG, L);
    __syncthreads();
    if (grp) out_wave<1, false>(A, TQ, TK, TV, TG, misc, m_prev, lg2g, w, lane, t0, 128, h); else out_wave<0, false>(A, TQ, TK, TV, TG, misc, 0.f, lg2g, w, lane, t0, 128, h);
    __syncthreads();
}
__device__ void phase_out_units(const Args& A, LAS unsigned char* lds) { for (int u = blockIdx.x; u < 1024; u += gridDim.x) out_unit(A, lds, u >> 4, u & 15); }

__device__ __forceinline__ f32x4 ld_bf4(const bf16_t* p) { const u32x2 w = *(const u32x2*)p; return (f32x4){__uint_as_float(w[0] << 16), __uint_as_float(w[0] & 0xffff0000u), __uint_as_float(w[1] << 16), __uint_as_float(w[1] & 0xffff0000u)}; }
__device__ __forceinline__ void st_bf4(bf16_t* p, const f32x4 v) { u32x2 w; w[0] = pk2(v[0], v[1]); w[1] = pk2(v[2], v[3]); *(u32x2*)p = w; }
__device__ void phase_norm(const Args& A) {
    const int lane = threadIdx.x & 63, wid = threadIdx.x >> 6;
    const bf16_t* MIXO = (const bf16_t*)(A.ws + WS_MIXO); bf16_t* X1 = (bf16_t*)(A.ws + WS_X1); bf16_t* H2 = (bf16_t*)(A.ws + WS_H2);
    for (int r = blockIdx.x * 8 + wid; r < T_ALL; r += gridDim.x * 8) {
        const float* x = xrow(A, r); const bf16_t* mo = MIXO + (size_t)r * DM; f32x4 v[4], xv[4]; float ss = 0.f;
#pragma unroll
        for (int q = 0; q < 4; ++q) { v[q] = ld_bf4(mo + q * 256 + lane * 4); xv[q] = *(const f32x4*)(x + q * 256 + lane * 4); ss += v[q][0] * v[q][0] + v[q][1] * v[q][1] + v[q][2] * v[q][2] + v[q][3] * v[q][3]; }
        ss = wave_sum(ss); const float rstd = rsqrtf(ss * (1.0f / 1024.0f) + 1e-6f); float s2 = 0.f;
#pragma unroll
        for (int q = 0; q < 4; ++q) { const f32x4 gp = *(const f32x4*)(A.in[13] + q * 256 + lane * 4);
            v[q] = xv[q] + v[q] * rstd * gp; st_bf4(X1 + (size_t)r * DM + q * 256 + lane * 4, v[q]); s2 += v[q][0] * v[q][0] + v[q][1] * v[q][1] + v[q][2] * v[q][2] + v[q][3] * v[q][3]; }
        s2 = wave_sum(s2); const float rstd2 = rsqrtf(s2 * (1.0f / 1024.0f) + 1e-6f);
#pragma unroll
        for (int q = 0; q < 4; ++q) { const f32x4 gp = *(const f32x4*)(A.in[14] + q * 256 + lane * 4); st_bf4(H2 + (size_t)r * DM + q * 256 + lane * 4, v[q] * rstd2 * gp); }
    }
}

__device__ __forceinline__ float gelu_tanh(float x) { const float y = x + 0.044715f * x * x * x; return x * __builtin_amdgcn_rcpf(1.0f + __builtin_amdgcn_exp2f(-2.302208198f * y)); }
__device__ __forceinline__ float dpp_ror1(float v) { return __int_as_float(__builtin_amdgcn_update_dpp(0, __float_as_int(v), 0x121, 0xf, 0xf, false)); }
__device__ __forceinline__ float dpp_ror2(float v) { return __int_as_float(__builtin_amdgcn_update_dpp(0, __float_as_int(v), 0x122, 0xf, 0xf, false)); }

struct EpiConv {
    static constexpr bool PERM = false, AFTER_DRAIN = false;
    bf16_t* act; float* edge; float* head; const float* cw; const float* cb; const float* cache; float* convs;
    __device__ __forceinline__ void operator()(const f32x4 (&acc)[2][2][4][2], const pg8::Unit& u, int wr, int wc, int fr, int fq) const {
        const bool sample = u.pm >= 64;
#pragma unroll
        for (int n = 0; n < 2; ++n) {
            const int j0 = 128 * u.pn + 32 * wc + 16 * n + 4 * fq;
            const f32x4 w0g = *(const f32x4*)(cw + j0), w1g = *(const f32x4*)(cw + NUP + j0), w2g = *(const f32x4*)(cw + 2 * NUP + j0), bg = *(const f32x4*)(cb + j0);
            const f32x4 w0v = *(const f32x4*)(cw + DFF + j0), w1v = *(const f32x4*)(cw + NUP + DFF + j0), w2v = *(const f32x4*)(cw + 2 * NUP + DFF + j0), bv = *(const f32x4*)(cb + DFF + j0);
#pragma unroll
            for (int ai = 0; ai < 2; ++ai)
#pragma unroll
                for (int m = 0; m < 4; ++m) {
                    const int r = u.pm * 256 + ai * 128 + wr * 64 + m * 16 + fr;
                    const f32x4 cg_ = acc[ai][0][m][n], cv_ = acc[ai][1][m][n];
                    f32x4 p1g, p2g, p1v, p2v; bool writeact = true;
                    if (!sample) {
                        f32x4 x1g = cg_, x2g = cg_, x1v = cv_, x2v = cv_;
                        if (m > 0) { const f32x4 pg_ = acc[ai][0][m > 0 ? m - 1 : 0][n], pv_ = acc[ai][1][m > 0 ? m - 1 : 0][n];
                            if (fr == 15) { x1g = pg_; x1v = pv_; } if (fr >= 14) { x2g = pg_; x2v = pv_; } }
#pragma unroll
                        for (int e = 0; e < 4; ++e) { p1g[e] = dpp_ror1(x1g[e]); p2g[e] = dpp_ror2(x2g[e]); p1v[e] = dpp_ror1(x1v[e]); p2v[e] = dpp_ror2(x2v[e]); }
                        const int G64 = r >> 6;
                        if (m == 0 && fr < 2) { writeact = false; float* hp = head + ((size_t)G64 * 2 + fr) * NUP + j0; *(f32x4*)hp = cg_; *(f32x4*)(hp + DFF) = cv_; }
                        if (m == 3 && fr >= 14) { float* ep = edge + ((size_t)G64 * 2 + (fr - 14)) * NUP + j0; *(f32x4*)ep = cg_; *(f32x4*)(ep + DFF) = cv_; }
                    } else {
#pragma unroll
                        for (int e = 0; e < 4; ++e) { p1g[e] = dpp_ror1(cg_[e]); p2g[e] = dpp_ror2(cg_[e]); p1v[e] = dpp_ror1(cv_[e]); p2v[e] = dpp_ror2(cv_[e]); }
                        const int sq = fr & 7, bb = (r - T_P) >> 3;
                        if (sq < 2) { const float* c0 = cache + (size_t)bb * 2 * NUP + j0; const f32x4 k0g = *(const f32x4*)c0, k0v = *(const f32x4*)(c0 + DFF), k1g = *(const f32x4*)(c0 + NUP), k1v = *(const f32x4*)(c0 + NUP + DFF);
                            if (sq == 0) { p2g = k0g; p2v = k0v; p1g = k1g; p1v = k1v; } else { p2g = k1g; p2v = k1v; } }
                        if (sq >= 6) { float* op = convs + ((size_t)bb * 2 + (sq - 6)) * NUP + j0; *(f32x4*)op = cg_; *(f32x4*)(op + DFF) = cv_; }
                    }
                    if (writeact) {
                        const f32x4 yg = w0g * p2g + w1g * p1g + w2g * cg_ + bg, yv = w0v * p2v + w1v * p1v + w2v * cv_ + bv;
                        u32x2 o; o[0] = pk2(gelu_tanh(yg[0]) * yv[0], gelu_tanh(yg[1]) * yv[1]); o[1] = pk2(gelu_tanh(yg[2]) * yv[2], gelu_tanh(yg[3]) * yv[3]);
                        *(u32x2*)(act + (size_t)r * DFF + j0) = o;
                    }
                }
        }
    }
};

__device__ void phase_conv_fixup(const Args& A) {
    const float* edge = (const float*)(A.ws + WS_EDGE); const float* head = (const float*)(A.ws + WS_HEAD); bf16_t* act = (bf16_t*)(A.ws + WS_ACT);
    const float* cw = A.in[16]; const float* cb = A.in[17];
    for (int idx = blockIdx.x * 512 + threadIdx.x; idx < 256 * 2 * 704; idx += gridDim.x * 512) {
        const int j0 = (idx % 704) * 4, rho = (idx / 704) & 1, G = idx / 1408;
        const float* hp = head + ((size_t)G * 2 + rho) * NUP + j0; const f32x4 cg_ = *(const f32x4*)hp, cv_ = *(const f32x4*)(hp + DFF);
        f32x4 p1g = {0.f, 0.f, 0.f, 0.f}, p2g = p1g, p1v = p1g, p2v = p1g;
        if ((G & 31) != 0) {
            const float* e0 = edge + ((size_t)(G - 1) * 2) * NUP + j0; const float* e1 = e0 + NUP;
            if (rho == 0) { p2g = *(const f32x4*)e0; p2v = *(const f32x4*)(e0 + DFF); p1g = *(const f32x4*)e1; p1v = *(const f32x4*)(e1 + DFF); }
            else { p2g = *(const f32x4*)e1; p2v = *(const f32x4*)(e1 + DFF); }
        }
        if (rho == 1) { const float* h0 = head + ((size_t)G * 2) * NUP + j0; p1g = *(const f32x4*)h0; p1v = *(const f32x4*)(h0 + DFF); }
        const f32x4 w0g = *(const f32x4*)(cw + j0), w1g = *(const f32x4*)(cw + NUP + j0), w2g = *(const f32x4*)(cw + 2 * NUP + j0), bg = *(const f32x4*)(cb + j0);
        const f32x4 w0v = *(const f32x4*)(cw + DFF + j0), w1v = *(const f32x4*)(cw + NUP + DFF + j0), w2v = *(const f32x4*)(cw + 2 * NUP + DFF + j0), bv = *(const f32x4*)(cb + DFF + j0);
        const f32x4 yg = w0g * p2g + w1g * p1g + w2g * cg_ + bg, yv = w0v * p2v + w1v * p1v + w2v * cv_ + bv;
        u32x2 o; o[0] = pk2(gelu_tanh(yg[0]) * yv[0], gelu_tanh(yg[1]) * yv[1]); o[1] = pk2(gelu_tanh(yg[2]) * yv[2], gelu_tanh(yg[3]) * yv[3]);
        *(u32x2*)(act + (size_t)(G * 64 + rho) * DFF + j0) = o;
    }
    for (int idx = blockIdx.x * 512 + threadIdx.x; idx < 8 * 2 * 1408; idx += gridDim.x * 512) {
        const int c4 = (idx % 1408) * 4, rho = (idx / 1408) & 1, b = idx / 2816;
        *(f32x4*)(A.out + O_BP + ((size_t)b * 2 + rho) * NUP + c4) = *(const f32x4*)(edge + ((size_t)(b * 32 + 31) * 2 + rho) * NUP + c4);
    }
}

__device__ void phase_final(const Args& A) {
    const int lane = threadIdx.x & 63, wid = threadIdx.x >> 6;
    const bf16_t* X1 = (const bf16_t*)(A.ws + WS_X1); const bf16_t* FFN = (const bf16_t*)(A.ws + WS_FFN);
    for (int r = blockIdx.x * 8 + wid; r < T_ALL; r += gridDim.x * 8) {
        float* y = A.out + (size_t)r * DM; f32x4 v[4], xv[4]; float ss = 0.f;
#pragma unroll
        for (int q = 0; q < 4; ++q) { v[q] = ld_bf4(FFN + (size_t)r * DM + q * 256 + lane * 4); xv[q] = ld_bf4(X1 + (size_t)r * DM + q * 256 + lane * 4); ss += v[q][0] * v[q][0] + v[q][1] * v[q][1] + v[q][2] * v[q][2] + v[q][3] * v[q][3]; }
        ss = wave_sum(ss); const float rstd = rsqrtf(ss * (1.0f / 1024.0f) + 1e-6f);
#pragma unroll
        for (int q = 0; q < 4; ++q) { const f32x4 gp = *(const f32x4*)(A.in[19] + q * 256 + lane * 4); *(f32x4*)(y + q * 256 + lane * 4) = xv[q] + v[q] * rstd * gp; }
    }
}

template <class Epi>
__device__ __forceinline__ void run_gemm(LAS unsigned char* lds, const bf16_t* Am, const bf16_t* Bt, int M, int N, int K, const Epi& E) {
    pg8::Gemm g; g.A = Am; g.Bt = Bt; g.M = M; g.N = N; g.K = K;
    pg8::StaticOrder S; S.init(M, N, (int)gridDim.x, (int)blockIdx.x);
    pg8::gemm_phase<Epi, pg8::StaticOrder, false>(lds, g, S, E, nullptr);
    __syncthreads();
}
template <int KSTEPS>
__device__ __forceinline__ void small_gemm_piece(LAS unsigned char* lds, const bf16_t* Am, const bf16_t* Bt, int K, int row0, int col0, bf16_t* C, int ldc) {
    int tid_ = threadIdx.x; OPAQUE(tid_); const int tid = tid_, lane = tid & 63, w = __builtin_amdgcn_readfirstlane(tid >> 6), g = lane >> 4, i = lane & 15;
    const bf16_t* ap = Am + (size_t)(row0 + i) * K + w * (KSTEPS * 32) + 8 * g;
    const bf16_t* bp = Bt + (size_t)(col0 + i) * K + w * (KSTEPS * 32) + 8 * g;
    f32x4 acc[4][4];
#pragma unroll
    for (int rb = 0; rb < 4; ++rb)
#pragma unroll
        for (int cb = 0; cb < 4; ++cb) acc[rb][cb] = (f32x4){0.f, 0.f, 0.f, 0.f};
    bf16x8 af[4], bfr[4];
#pragma unroll
    for (int rb = 0; rb < 4; ++rb) { af[rb] = *(const bf16x8*)(ap + (size_t)rb * 16 * K); bfr[rb] = *(const bf16x8*)(bp + (size_t)rb * 16 * K); }
#pragma unroll 1
    for (int s = 0; s < KSTEPS; ++s) {
        bf16x8 an[4], bn[4];
        const int sn = (s + 1 < KSTEPS) ? s + 1 : s;
#pragma unroll
        for (int rb = 0; rb < 4; ++rb) { an[rb] = *(const bf16x8*)(ap + (size_t)rb * 16 * K + 32 * sn); bn[rb] = *(const bf16x8*)(bp + (size_t)rb * 16 * K + 32 * sn); }
#pragma unroll
        for (int rb = 0; rb < 4; ++rb)
#pragma unroll
            for (int cb = 0; cb < 4; ++cb) acc[rb][cb] = MFMA16(af[rb], bfr[cb], acc[rb][cb]);
#pragma unroll
        for (int rb = 0; rb < 4; ++rb) { af[rb] = an[rb]; bfr[rb] = bn[rb]; }
    }
    LAS float* P = (LAS float*)lds + w * 4096;
#pragma unroll
    for (int rb = 0; rb < 4; ++rb)
#pragma unroll
        for (int cb = 0; cb < 4; ++cb)
#pragma unroll
            for (int r = 0; r < 4; ++r) P[(16 * rb + 4 * g + r) * 64 + 16 * cb + i] = acc[rb][cb][r];
    __syncthreads();
    const LAS float* Q = (const LAS float*)lds;
#pragma unroll
    for (int k = 0; k < 4; ++k) {
        const int e = (tid + 512 * k) * 2;
        float s0 = 0.f, s1 = 0.f;
#pragma unroll
        for (int ww = 0; ww < 8; ++ww) { s0 += Q[ww * 4096 + e]; s1 += Q[ww * 4096 + e + 1]; }
        *(unsigned*)(C + (size_t)(row0 + (e >> 6)) * ldc + col0 + (e & 63)) = pk2(s0, s1);
    }
    __syncthreads();
}
template <int KSTEPS>
__device__ __forceinline__ void small_gemm_rows(LAS unsigned char* lds, const bf16_t* Am, const bf16_t* Bt, int K, int N, bf16_t* C, int ldc) {
    const int ncb = N / 64, np = 16 * ncb;
    for (int p = blockIdx.x; p < np; p += gridDim.x) small_gemm_piece<KSTEPS>(lds, Am, Bt, K, T_P + 64 * (p / ncb), 64 * (p % ncb), C, ldc);
}

#define XB_TMO      128
#define XB_XCNT(j)  (256  + 64 * (j))
#define XB_XSUB(j)  (1280 + 64 * (j))
#define XB_XGEN(j)  (2304 + 64 * (j))
#define XB_TOP      3328
#define XB_TOPGEN   3392
#define XCD_BAR_WORDS 3456
#define XB_SPIN_CAP (1u << 18)
__device__ __forceinline__ unsigned xb_ld(unsigned* p)              { return __hip_atomic_load(p, __ATOMIC_RELAXED, __HIP_MEMORY_SCOPE_AGENT); }
__device__ __forceinline__ unsigned xb_add(unsigned* p, unsigned v) { return __hip_atomic_fetch_add(p, v, __ATOMIC_RELAXED, __HIP_MEMORY_SCOPE_AGENT); }
__device__ __forceinline__ unsigned xb_xcc_id() { return (unsigned)__builtin_amdgcn_s_getreg((3 << 11) | 20) & 0xFu; }
#define XB_SPIN(cond, bar) do { unsigned _sp = 0; while (cond) { __builtin_amdgcn_s_sleep(1); \
    if ((++_sp & 255u) == 0u) { if (xb_ld(&(bar)[XB_TMO])) break; if (_sp > XB_SPIN_CAP) { atomicAdd(&(bar)[XB_TMO], 1u); break; } } } } while (0)
struct XcdBarrier { unsigned* bar; unsigned x; volatile LAS unsigned* st; };
__device__ __forceinline__ XcdBarrier xcd_barrier_post(unsigned* bar, volatile LAS unsigned* st) {
    XcdBarrier b; b.bar = bar; b.x = xb_xcc_id(); b.st = st;
    if (threadIdx.x == 0) (void)xb_add(&bar[XB_XCNT(b.x)], 1u);
    return b;
}
__device__ __forceinline__ void xcd_barrier_complete(unsigned* bar, unsigned x, unsigned& nloc, unsigned& nx) {
    const unsigned G = gridDim.x * gridDim.y * gridDim.z;
    unsigned sum, cnt, mine, sp = 0u;
    for (;;) {
        sum = 0u; cnt = 0u; mine = 0u;
#pragma unroll
        for (unsigned j = 0; j < 16; ++j) { const unsigned c = xb_ld(&bar[XB_XCNT(j)]); sum += c; cnt += (c > 0u) ? 1u : 0u; mine = (j == x) ? c : mine; }
        if (sum == G) break;
        __builtin_amdgcn_s_sleep(1);
        if ((++sp & 255u) == 0u) { if (xb_ld(&bar[XB_TMO])) break; if (sp > XB_SPIN_CAP) { atomicAdd(&bar[XB_TMO], 1u); break; } }
    }
    nloc = mine > 0u ? mine : 1u; nx = cnt > 0u ? cnt : 1u;
}
__device__ __forceinline__ void xcd_barrier(const XcdBarrier& b) {
    asm volatile("s_waitcnt vmcnt(0)" ::: "memory");
    __syncthreads();
    if (threadIdx.x == 0) {
        unsigned* bar = b.bar;
        __builtin_amdgcn_s_waitcnt(0);
        unsigned nloc = b.st[0], nx = b.st[1];
        if (nloc == 0u) { xcd_barrier_complete(bar, b.x, nloc, nx); b.st[0] = nloc; b.st[1] = nx; }
        const unsigned old = xb_add(&bar[XB_XSUB(b.x)], 1u);
        const unsigned gen = old / nloc;
        if (old + 1u == (gen + 1u) * nloc) {
            __builtin_amdgcn_fence(__ATOMIC_RELEASE, "agent");
            asm volatile("s_waitcnt vmcnt(0)" ::: "memory");
            const unsigned og = xb_add(&bar[XB_TOP], 1u);
            const unsigned tg = og / nx;
            if (og + 1u == (tg + 1u) * nx) xb_add(&bar[XB_TOPGEN], 1u);
            else XB_SPIN(xb_ld(&bar[XB_TOPGEN]) == tg, bar);
            __builtin_amdgcn_fence(__ATOMIC_ACQUIRE, "agent");
            xb_add(&bar[XB_XGEN(b.x)], 1u);
            asm volatile("s_waitcnt vmcnt(0)" ::: "memory");
        } else {
            XB_SPIN(xb_ld(&bar[XB_XGEN(b.x)]) == gen, bar);
            __builtin_amdgcn_fence(__ATOMIC_ACQUIRE, "agent");
            asm volatile("s_waitcnt vmcnt(0)" ::: "memory");
        }
    }
    __syncthreads();
}

#ifndef DUPMASK
#define DUPMASK 0
#endif
#ifndef EXTRA_SYNCS
#define EXTRA_SYNCS 0
#endif
#define NREP(bit) ((DUPMASK & (bit)) ? 2 : 1)
__global__ void __launch_bounds__(512) fwd_kernel(Args A) {
    extern __shared__ __attribute__((aligned(16))) unsigned char shm[];
    LAS unsigned char* lds = (LAS unsigned char*)shm;
    cg::grid_group grid = cg::this_grid();
    if (A.out == nullptr) grid.sync();
    if (threadIdx.x < 4) ((LAS unsigned*)(lds + MISC_OFF + 3072))[threadIdx.x] = 0u;
    __syncthreads();
    const XcdBarrier xb = xcd_barrier_post((unsigned*)(A.ws + WS_BAR), (volatile LAS unsigned*)(lds + MISC_OFF + 3072));
#pragma unroll 1
    for (int rp = 0; rp < NREP(1); ++rp) { phase_convert_weights(A, lds); phase_prep_rows(A); phase_rope_table(A); }
    xcd_barrier(xb);
    phase_gate_scan(A);
#pragma unroll 1
    for (int rp = 0; rp < NREP(4); ++rp) { pg8::EpiBf16<0> E; E.O = (bf16_t*)(A.ws + WS_PROJ); E.ldc = NPROJ; E.bias = nullptr; E.split_cols = 0; E.split_stride = 0;
      small_gemm_rows<4>(lds, (const bf16_t*)(A.ws + WS_H), (const bf16_t*)(A.ws + WS_WIN), 1024, NPROJ, (bf16_t*)(A.ws + WS_PROJ), NPROJ);
      run_gemm(lds, (const bf16_t*)(A.ws + WS_H), (const bf16_t*)(A.ws + WS_WIN), T_P, NPROJ, 1024, E); }
    xcd_barrier(xb);
#pragma unroll 1
    for (int rp = 0; rp < NREP(8); ++rp) phase_local_and_sample(A, lds);
    xcd_barrier(xb);
    phase_scan(A);
    xcd_barrier(xb);
#pragma unroll 1
    for (int rp = 0; rp < NREP(32); ++rp) phase_out_units(A, lds);
    xcd_barrier(xb);
#pragma unroll 1
    for (int rp = 0; rp < NREP(64); ++rp) { pg8::EpiBf16<0> E; E.O = (bf16_t*)(A.ws + WS_MIXO); E.ldc = DM; E.bias = nullptr; E.split_cols = 0; E.split_stride = 0;
      small_gemm_rows<4>(lds, (const bf16_t*)(A.ws + WS_MIXIN), (const bf16_t*)(A.ws + WS_WOUT), 1024, 1024, (bf16_t*)(A.ws + WS_MIXO), DM);
      run_gemm(lds, (const bf16_t*)(A.ws + WS_MIXIN), (const bf16_t*)(A.ws + WS_WOUT), T_P, 1024, 1024, E); }
    xcd_barrier(xb);
#pragma unroll 1
    for (int rp = 0; rp < NREP(128); ++rp) phase_norm(A);
    xcd_barrier(xb);
#pragma unroll 1
    for (int rp = 0; rp < NREP(256); ++rp) { EpiConv E; E.act = (bf16_t*)(A.ws + WS_ACT); E.edge = (float*)(A.ws + WS_EDGE); E.head = (float*)(A.ws + WS_HEAD); E.cw = A.in[16]; E.cb = A.in[17]; E.cache = A.in[6]; E.convs = A.out + O_BS;
      run_gemm(lds, (const bf16_t*)(A.ws + WS_H2), (const bf16_t*)(A.ws + WS_WUP), T_ALL, NUP, 1024, E); }
    xcd_barrier(xb);
    phase_conv_fixup(A);
    xcd_barrier(xb);
#pragma unroll 1
    for (int rp = 0; rp < NREP(1024); ++rp) { pg8::EpiBf16<0> E; E.O = (bf16_t*)(A.ws + WS_FFN); E.ldc = DM; E.bias = nullptr; E.split_cols = 0; E.split_stride = 0;
      small_gemm_rows<11>(lds, (const bf16_t*)(A.ws + WS_ACT), (const bf16_t*)(A.ws + WS_WDOWN), DFF, 1024, (bf16_t*)(A.ws + WS_FFN), DM);
      run_gemm(lds, (const bf16_t*)(A.ws + WS_ACT), (const bf16_t*)(A.ws + WS_WDOWN), T_P, 1024, DFF, E); }
    xcd_barrier(xb);
    phase_final(A);
#pragma unroll 1
    for (int rp = 0; rp < EXTRA_SYNCS; ++rp) xcd_barrier(xb);
}

extern "C" void kernel_launch(void* const* d_in, const int* in_sizes, int n_in, void* d_out, int out_size, void* d_ws, size_t ws_size, hipStream_t stream) {
    static int grid = 0;
    if (grid == 0) {
        int dev = 0, cus = 0, per_cu = 0;
        hipGetDevice(&dev); hipDeviceGetAttribute(&cus, hipDeviceAttributeMultiprocessorCount, dev);
        hipFuncSetAttribute((const void*)fwd_kernel, hipFuncAttributeMaxDynamicSharedMemorySize, LDS_BYTES);
        hipOccupancyMaxActiveBlocksPerMultiprocessor(&per_cu, (const void*)fwd_kernel, 512, LDS_BYTES);
        if (per_cu < 1) per_cu = 1;
        if (per_cu > 1) per_cu = 1;
        grid = cus * per_cu; (void)hipGetLastError();
        if (ws_size < 256 * MiB) fprintf(stderr, "kernel_launch: workspace too small (%zu)\n", ws_size);
    }
    Args a{};
    for (int i = 0; i < 20; ++i) a.in[i] = (const float*)d_in[i];
    a.out = (float*)d_out; a.ws = (unsigned char*)d_ws;
    (void)hipMemsetAsync((unsigned char*)d_ws + WS_BAR, 0, XCD_BAR_WORDS * 4, stream);
    void* args[] = {&a};
    hipError_t e = hipLaunchCooperativeKernel((const void*)fwd_kernel, dim3(grid), dim3(512), args, LDS_BYTES, stream);
    if (e != hipSuccess) fprintf(stderr, "cooperative launch failed: %s (grid %d)\n", hipGetErrorString(e), grid);
}
```
